# Optimizing an MI355X kernel written in HIP

```python
import jax, jax.numpy as jnp
from jax import lax
import numpy as np

D_MODEL = 2048
BATCH = 8
SEQ = 4096
DEPTH = 4

CHUNK = 64
Q_BLOCK = 128
N_MIXERS = 2
N_MLA_LAYERS = (DEPTH + 1) // 2
N_FOX_LAYERS = DEPTH // 2
RMS_EPS = 1e-6
NEG_INF = -1e30
MAX_POS_OFFSET = 8192

MLA_HEADS = D_MODEL // 128
MLA_Q_LORA = 512
MLA_KV_LORA = 512
MLA_NOPE = 128
MLA_ROPE = 64
MLA_V = 128
ROPE_THETA = 10000.0

FOX_HEAD_DIM = 128
FOX_HEADS = D_MODEL // FOX_HEAD_DIM
FOX_FORGET_BIAS = 3.0

MOE_GROUPS = 8
MOE_EXPERTS_PER_GROUP = 4
MOE_EXPERTS = MOE_GROUPS * MOE_EXPERTS_PER_GROUP
MOE_TOP_K = 2
MOE_D_FF = D_MODEL // 4

kernel_name = "hybrid_mla_fox_hmoe_streaming_trunk"


def rmsnorm(x, gain):
    xf = x.astype(jnp.float32)
    y = xf * lax.rsqrt(jnp.mean(xf * xf, axis=-1, keepdims=True) + RMS_EPS)
    return (y * gain.astype(jnp.float32)).astype(x.dtype)


def rope_tables(positions):
    inv_freq = ROPE_THETA ** (-jnp.arange(0, MLA_ROPE, 2, dtype=jnp.float32) / MLA_ROPE)
    ang = positions.astype(jnp.float32)[..., None] * inv_freq
    return jnp.cos(ang), jnp.sin(ang)


def apply_rope(x, cos, sin):
    xf = x.astype(jnp.float32)
    half = xf.shape[-1] // 2
    x1, x2 = xf[..., :half], xf[..., half:]
    c, s = cos[:, :, None, :], sin[:, :, None, :]
    return jnp.concatenate([x1 * c - x2 * s, x2 * c + x1 * s], axis=-1).astype(x.dtype)


def blocked_attention(q, k, v, scale, logit_bias):
    B, S, H, dq = q.shape
    dv = v.shape[-1]
    nb = S // Q_BLOCK
    qb = jnp.moveaxis(q.reshape(B, nb, Q_BLOCK, H, dq), 1, 0)

    def one_block(args):
        i, q_i = args
        qpos = i * Q_BLOCK + jnp.arange(Q_BLOCK)
        s = jnp.einsum('bqhd,bkhd->bhqk', q_i, k, preferred_element_type=jnp.float32) * scale
        s = s + logit_bias(i, qpos)
        p = jax.nn.softmax(s, axis=-1).astype(v.dtype)
        return jnp.einsum('bhqk,bkhd->bqhd', p, v)

    o = lax.map(one_block, (jnp.arange(nb), qb))
    return jnp.moveaxis(o, 0, 1).reshape(B, S, H, dv)


def mla_mixer(x, cos, sin, w_dq, q_norm, w_uq, w_dkv, kv_norm, w_ukv, w_o):
    B, S, _ = x.shape
    H = MLA_HEADS
    c_q = rmsnorm(x @ w_dq, q_norm)
    q = (c_q @ w_uq).reshape(B, S, H, MLA_NOPE + MLA_ROPE)
    q = jnp.concatenate([q[..., :MLA_NOPE], apply_rope(q[..., MLA_NOPE:], cos, sin)], axis=-1)
    kv_a = x @ w_dkv
    c_kv = rmsnorm(kv_a[..., :MLA_KV_LORA], kv_norm)
    k_pe = apply_rope(kv_a[..., None, MLA_KV_LORA:], cos, sin)
    kv = (c_kv @ w_ukv).reshape(B, S, H, MLA_NOPE + MLA_V)
    k = jnp.concatenate([kv[..., :MLA_NOPE], jnp.broadcast_to(k_pe, (B, S, H, MLA_ROPE))], axis=-1)
    v = kv[..., MLA_NOPE:]
    k_chunk = jnp.arange(S) // CHUNK

    def chunk_mask(i, qpos):
        allowed = k_chunk[None, :] <= (qpos // CHUNK)[:, None]
        return jnp.where(allowed, 0.0, NEG_INF).astype(jnp.float32)

    o = blocked_attention(q, k, v, (MLA_NOPE + MLA_ROPE) ** -0.5, chunk_mask)
    return o.reshape(B, S, H * MLA_V) @ w_o


def fox_mixer(x, w_qkv, q_norm, k_norm, w_f, b_f, w_og, w_o):
    B, S, _ = x.shape
    H, dh = FOX_HEADS, FOX_HEAD_DIM
    qkv = (x @ w_qkv).reshape(B, S, 3, H, dh)
    q = rmsnorm(qkv[:, :, 0], q_norm)
    k = rmsnorm(qkv[:, :, 1], k_norm)
    v = qkv[:, :, 2]
    log_f = jax.nn.log_sigmoid((x @ w_f + b_f).astype(jnp.float32))
    c = jnp.cumsum(log_f, axis=1).transpose(0, 2, 1)
    kpos = jnp.arange(S)

    def forget_bias(i, qpos):
        c_q = lax.dynamic_slice_in_dim(c, i * Q_BLOCK, Q_BLOCK, axis=2)
        allowed = kpos[None, :] <= qpos[:, None]
        return jnp.where(allowed, c_q[..., :, None] - c[..., None, :], NEG_INF)

    o = blocked_attention(q, k, v, dh ** -0.5, forget_bias)
    gate = jax.nn.sigmoid(x @ w_og)
    return (o.reshape(B, S, H * dh) * gate) @ w_o


def hier_moe(h, w_grp, b_grp, w_rt, b_rt, w_gate, w_up, w_down):
    B, S, D = h.shape
    t = h.reshape(B * S, D)
    T = t.shape[0]
    grp_logits = jnp.einsum('td,dg->tg', t, w_grp, preferred_element_type=jnp.float32) + b_grp.astype(jnp.float32)
    grp_prob = jax.nn.softmax(grp_logits, axis=-1)
    g_sel = jnp.argmax(grp_logits, axis=-1)
    g_w = jnp.take_along_axis(grp_prob, g_sel[:, None], axis=1)
    ex_logits = (jnp.einsum('td,de->te', t, w_rt, preferred_element_type=jnp.float32)
                 + b_rt.astype(jnp.float32)).reshape(T, MOE_GROUPS, MOE_EXPERTS_PER_GROUP)
    idx = jnp.broadcast_to(g_sel[:, None, None], (T, 1, MOE_EXPERTS_PER_GROUP))
    in_grp = jnp.take_along_axis(ex_logits, idx, axis=1)[:, 0]
    in_prob = jax.nn.softmax(in_grp, axis=-1)
    top_w, top_j = lax.top_k(in_prob, MOE_TOP_K)
    top_w = top_w / jnp.sum(top_w, axis=-1, keepdims=True) * g_w
    expert_id = g_sel[:, None] * MOE_EXPERTS_PER_GROUP + top_j
    gates = jnp.sum(jax.nn.one_hot(expert_id, MOE_EXPERTS, dtype=jnp.float32) * top_w[..., None], axis=1)

    def expert_step(acc, p):
        wg, wu, wd, gate_e = p
        hid = jax.nn.silu(t @ wg) * (t @ wu)
        out = jnp.einsum('tf,fd->td', hid, wd, preferred_element_type=jnp.float32)
        return acc + gate_e[:, None] * out, None

    acc, _ = lax.scan(expert_step, jnp.zeros((T, D), jnp.float32), (w_gate, w_up, w_down, gates.T))
    return acc.astype(h.dtype).reshape(B, S, D)


def setup_inputs(seed: int = 0) -> dict:
    key = jax.random.key(seed)
    ks = jax.random.split(key, 32)
    f32 = jnp.float32

    def nrm(k, shape, fan_in):
        return jax.random.normal(k, shape, f32) * (fan_in ** -0.5)

    def gain(k, shape):
        return 1.0 + 0.05 * jax.random.normal(k, shape, f32)

    D, H, dh = D_MODEL, FOX_HEADS, FOX_HEAD_DIM
    x = jax.random.normal(ks[0], (BATCH, SEQ, D), f32)
    positions = (jnp.arange(SEQ, dtype=jnp.int32)[None, :]
                 + jax.random.randint(ks[1], (BATCH, 1), 0, MAX_POS_OFFSET, dtype=jnp.int32))
    return {
        'x': x,
        'positions': positions,
        'attn_norm': gain(ks[2], (DEPTH, D)),
        'ffn_norm': gain(ks[3], (DEPTH, D)),
        'final_norm': gain(ks[4], (D,)),
        'mla_w_dq': nrm(ks[5], (N_MLA_LAYERS, D, MLA_Q_LORA), D),
        'mla_q_norm': gain(ks[6], (N_MLA_LAYERS, MLA_Q_LORA)),
        'mla_w_uq': nrm(ks[7], (N_MLA_LAYERS, MLA_Q_LORA, MLA_HEADS * (MLA_NOPE + MLA_ROPE)), MLA_Q_LORA),
        'mla_w_dkv': nrm(ks[8], (N_MLA_LAYERS, D, MLA_KV_LORA + MLA_ROPE), D),
        'mla_kv_norm': gain(ks[9], (N_MLA_LAYERS, MLA_KV_LORA)),
        'mla_w_ukv': nrm(ks[10], (N_MLA_LAYERS, MLA_KV_LORA, MLA_HEADS * (MLA_NOPE + MLA_V)), MLA_KV_LORA),
        'mla_w_o': nrm(ks[11], (N_MLA_LAYERS, MLA_HEADS * MLA_V, D), MLA_HEADS * MLA_V),
        'fox_w_qkv': nrm(ks[12], (N_FOX_LAYERS, D, 3 * H * dh), D),
        'fox_q_norm': gain(ks[13], (N_FOX_LAYERS, dh)),
        'fox_k_norm': gain(ks[14], (N_FOX_LAYERS, dh)),
        'fox_w_f': nrm(ks[15], (N_FOX_LAYERS, D, H), D),
        'fox_b_f': FOX_FORGET_BIAS + 0.5 * jax.random.normal(ks[16], (N_FOX_LAYERS, H), f32),
        'fox_w_og': nrm(ks[17], (N_FOX_LAYERS, D, H * dh), D),
        'fox_w_o': nrm(ks[18], (N_FOX_LAYERS, H * dh, D), H * dh),
        'moe_w_grp': nrm(ks[19], (DEPTH, D, MOE_GROUPS), D),
        'moe_b_grp': 0.01 * jax.random.normal(ks[20], (DEPTH, MOE_GROUPS), f32),
        'moe_w_rt': nrm(ks[21], (DEPTH, D, MOE_EXPERTS), D),
        'moe_b_rt': 0.01 * jax.random.normal(ks[22], (DEPTH, MOE_EXPERTS), f32),
        'moe_w_gate': nrm(ks[23], (DEPTH, MOE_EXPERTS, D, MOE_D_FF), D),
        'moe_w_up': nrm(ks[24], (DEPTH, MOE_EXPERTS, D, MOE_D_FF), D),
        'moe_w_down': nrm(ks[25], (DEPTH, MOE_EXPERTS, MOE_D_FF, D), MOE_D_FF),
    }


def reference(x, positions, attn_norm, ffn_norm, final_norm,
              mla_w_dq, mla_q_norm, mla_w_uq, mla_w_dkv, mla_kv_norm, mla_w_ukv, mla_w_o,
              fox_w_qkv, fox_q_norm, fox_k_norm, fox_w_f, fox_b_f, fox_w_og, fox_w_o,
              moe_w_grp, moe_b_grp, moe_w_rt, moe_b_rt, moe_w_gate, moe_w_up, moe_w_down):
    cos, sin = rope_tables(positions)
    h = x
    for i in range(DEPTH):
        a = rmsnorm(h, attn_norm[i])
        j = i // N_MIXERS
        if i % N_MIXERS == 0:
            mix = mla_mixer(a, cos, sin, mla_w_dq[j], mla_q_norm[j], mla_w_uq[j],
                            mla_w_dkv[j], mla_kv_norm[j], mla_w_ukv[j], mla_w_o[j])
        else:
            mix = fox_mixer(a, fox_w_qkv[j], fox_q_norm[j], fox_k_norm[j],
                            fox_w_f[j], fox_b_f[j], fox_w_og[j], fox_w_o[j])
        h = h + mix
        h = h + hier_moe(rmsnorm(h, ffn_norm[i]), moe_w_grp[i], moe_b_grp[i], moe_w_rt[i],
                         moe_b_rt[i], moe_w_gate[i], moe_w_up[i], moe_w_down[i])
    return rmsnorm(h, final_norm)
```

```cpp
#include <hip/hip_runtime.h>
#include <cstdio>
#include <cstdint>

typedef unsigned short bf16_t;
typedef float f32x4 __attribute__((ext_vector_type(4)));
typedef unsigned u32x4 __attribute__((ext_vector_type(4)));
typedef unsigned u32x2 __attribute__((ext_vector_type(2)));

constexpr int T = 32768, D = 2048, NB = 8, S = 4096, NH = 16, DH = 128;
constexpr int QL = 512, KVL = 512, ROPE = 64;
constexpr int NE = 32, NG = 8, EPG = 4, FF = 512;
constexpr int ECAP = 32768;
constexpr int HID_ROWS = 73728;
constexpr float EPS = 1e-6f;
constexpr float LOG2E = 1.4426950408889634f;
constexpr float QS_MLA = 0.07216878364870322f * LOG2E;
constexpr float QS_FOX = 0.08838834764831845f * LOG2E;

constexpr size_t MiB = 1ull << 20;
constexpr size_t WS_CTL = 0, CTL_BYTES = 1 * MiB;
constexpr size_t WS_ROPE = 1 * MiB;
constexpr size_t WS_LOGF = 9 * MiB;
constexpr size_t WS_NCK = 11 * MiB;
constexpr size_t WS_ROWLIST = 16 * MiB;
constexpr size_t WS_ROWW = 20 * MiB;
constexpr size_t WS_KR = 24 * MiB;
constexpr size_t WS_ABF = 928 * MiB;
constexpr size_t WS_Y2 = 1056 * MiB;
constexpr size_t WS_ARENA = 1312 * MiB;
constexpr size_t WS_RAW = WS_ARENA;
constexpr size_t WS_CQ = WS_ARENA + 80 * MiB;
constexpr size_t WS_CKV = WS_ARENA + 112 * MiB;
constexpr size_t WS_QN = WS_ARENA + 144 * MiB;
constexpr size_t WS_QR = WS_ARENA + 272 * MiB;
constexpr size_t WS_KN = WS_ARENA + 336 * MiB;
constexpr size_t WS_V = WS_ARENA + 464 * MiB;
constexpr size_t WS_FQ = WS_ARENA;
constexpr size_t WS_FK = WS_ARENA + 128 * MiB;
constexpr size_t WS_FV = WS_ARENA + 256 * MiB;
constexpr size_t WS_FG = WS_ARENA + 384 * MiB;
constexpr size_t WS_HID = WS_ARENA;
constexpr size_t WS_END = 2048 * MiB;
constexpr int CW_CNT = 1024;

struct Ptrs {
    const float* in[26]; float* out; unsigned char* ws;
};

__device__ __forceinline__ float bf2f(bf16_t v) { return __uint_as_float((unsigned)v << 16); }
__device__ __forceinline__ unsigned f2bf(float f) { unsigned u = __float_as_uint(f); return (u + 0x7fffu + ((u >> 16) & 1u)) >> 16; }
__device__ __forceinline__ unsigned pk2(float lo, float hi) { return f2bf(lo) | (f2bf(hi) << 16); }
__device__ __forceinline__ float bfr(float f) { return __uint_as_float(f2bf(f) << 16); }
__device__ __forceinline__ float wave_sum(float v) {
#pragma unroll
    for (int o = 32; o >= 1; o >>= 1) v += __shfl_xor(v, o);
    return v;
}
__device__ __forceinline__ float wave_max(float v) {
#pragma unroll
    for (int o = 32; o >= 1; o >>= 1) v = fmaxf(v, __shfl_xor(v, o));
    return v;
}

__global__ void k_rope_table(const int* pos, float2* cs) {
    const int i = blockIdx.x * blockDim.x + threadIdx.x; if (i >= T * 32) return;
    const int t = i >> 5, f = i & 31;
    const float inv = powf(10000.0f, -(float)(2 * f) / 64.0f);
    const float ang = (float)pos[t] * inv;
    cs[i] = make_float2((float)cos((double)ang), (float)sin((double)ang));
}

template <int MODE  >
__global__ void __launch_bounds__(512) k_norm(const float* src, float* h, const bf16_t* y2, const float* gain, bf16_t* abf) {
    const int row = blockIdx.x * 8 + (threadIdx.x >> 6), lane = threadIdx.x & 63;
    const f32x4* s4 = (const f32x4*)(src + (size_t)row * D) + lane;
    f32x4 v[8]; float ss = 0.f;
#pragma unroll
    for (int j = 0; j < 8; ++j) v[j] = s4[64 * j];
    if (MODE == 1) {
        const u32x2* ya = (const u32x2*)(y2 + (size_t)(2 * row) * D) + lane; const u32x2* yb = (const u32x2*)(y2 + (size_t)(2 * row + 1) * D) + lane;
#pragma unroll
        for (int j = 0; j < 8; ++j) { const u32x2 a = ya[64 * j], b = yb[64 * j];
            v[j][0] += __uint_as_float(a.x << 16) + __uint_as_float(b.x << 16); v[j][1] += __uint_as_float(a.x & 0xffff0000u) + __uint_as_float(b.x & 0xffff0000u);
            v[j][2] += __uint_as_float(a.y << 16) + __uint_as_float(b.y << 16); v[j][3] += __uint_as_float(a.y & 0xffff0000u) + __uint_as_float(b.y & 0xffff0000u); }
    }
#pragma unroll
    for (int j = 0; j < 8; ++j) ss += (v[j][0] * v[j][0] + v[j][1] * v[j][1]) + (v[j][2] * v[j][2] + v[j][3] * v[j][3]);
    const float rstd = 1.0f / sqrtf(wave_sum(ss) * (1.0f / D) + EPS);
    const f32x4* g4 = (const f32x4*)gain + lane;
    if (MODE == 2) {
        f32x4* o4 = (f32x4*)(h + (size_t)row * D) + lane;
#pragma unroll
        for (int j = 0; j < 8; ++j) o4[64 * j] = v[j] * rstd * g4[64 * j];
    } else {
        if (MODE == 0 || MODE == 1) { f32x4* o4 = (f32x4*)(h + (size_t)row * D) + lane;
#pragma unroll
            for (int j = 0; j < 8; ++j) o4[64 * j] = v[j]; }
        u32x2* a2 = (u32x2*)(abf + (size_t)row * D) + lane;
#pragma unroll
        for (int j = 0; j < 8; ++j) { const f32x4 o = v[j] * rstd * g4[64 * j]; u32x2 w; w.x = pk2(o[0], o[1]); w.y = pk2(o[2], o[3]); a2[64 * j] = w; }
    }
}

__device__ __forceinline__ void dot2(const bf16_t* __restrict__ arow, int K, const float* __restrict__ p0, const float* __restrict__ p1, int ld, float& v0, float& v1) {
    float a0 = 0.f, a1 = 0.f;
    for (int k = 0; k < K; k += 8) {
        const u32x4 av = *(const u32x4*)(arow + k);
        const unsigned w[4] = {av.x, av.y, av.z, av.w};
#pragma unroll
        for (int j = 0; j < 4; ++j) {
            const float x0 = __uint_as_float(w[j] << 16), x1 = __uint_as_float(w[j] & 0xffff0000u);
            const size_t o0 = (size_t)(k + 2 * j) * ld, o1 = o0 + ld;
            a0 = fmaf(x0, p0[o0], a0); a1 = fmaf(x0, p1[o0], a1);
            a0 = fmaf(x1, p0[o1], a0); a1 = fmaf(x1, p1[o1], a1);
        }
    }
    v0 = a0; v1 = a1;
}

__global__ void k_n_mla_a(const bf16_t* abf, const float* wdq, const float* wdkv, bf16_t* raw) {
    const int c = blockIdx.x * 256 + threadIdx.x, row = blockIdx.y; if (c >= 544) return;
    const int n = 2 * c; const float* p; int ld;
    if (n < 512) { p = wdq + n; ld = 512; } else { p = wdkv + (n - 512); ld = 576; }
    float v0, v1; dot2(abf + (size_t)row * D, D, p, p + 1, ld, v0, v1);
    *(unsigned*)(raw + (size_t)row * 1280 + n) = pk2(v0, v1);
}
__global__ void __launch_bounds__(512) k_mla_prep(const bf16_t* raw, const float* qn, const float* kvn, const float2* cs, bf16_t* cq, bf16_t* ckv, bf16_t* kr) {
    const int row = blockIdx.x * 8 + (threadIdx.x >> 6), lane = threadIdx.x & 63;
    const bf16_t* r = raw + (size_t)row * 1280;
#pragma unroll
    for (int part = 0; part < 2; ++part) {
        const u32x4 v = *(const u32x4*)(r + part * 512 + 8 * lane); const unsigned w[4] = {v.x, v.y, v.z, v.w};
        float x[8]; float ss = 0.f;
#pragma unroll
        for (int j = 0; j < 4; ++j) { x[2 * j] = __uint_as_float(w[j] << 16); x[2 * j + 1] = __uint_as_float(w[j] & 0xffff0000u); ss += x[2 * j] * x[2 * j] + x[2 * j + 1] * x[2 * j + 1]; }
        const float rstd = 1.0f / sqrtf(wave_sum(ss) * (1.0f / 512.0f) + EPS);
        const float* g = (part ? kvn : qn) + 8 * lane;
        u32x4 o; o.x = pk2(x[0] * rstd * g[0], x[1] * rstd * g[1]); o.y = pk2(x[2] * rstd * g[2], x[3] * rstd * g[3]); o.z = pk2(x[4] * rstd * g[4], x[5] * rstd * g[5]); o.w = pk2(x[6] * rstd * g[6], x[7] * rstd * g[7]);
        *(u32x4*)((part ? ckv : cq) + (size_t)row * 512 + 8 * lane) = o;
    }
    if (lane < 32) {
        const float x1 = bf2f(r[1024 + lane]), x2 = bf2f(r[1024 + 32 + lane]); const float2 c = cs[(size_t)row * 32 + lane];
        *(unsigned*)(kr + (size_t)row * 64 + 2 * lane) = pk2(x1 * c.x - x2 * c.y, x2 * c.x + x1 * c.y);
    }
}
__global__ void k_n_mla_uq(const bf16_t* cq, const float* wuq, const float2* cs, bf16_t* Qn, bf16_t* Qr) {
    const int c = blockIdx.x * 256 + threadIdx.x, row = blockIdx.y;
    float v0, v1;
    if (c < 1024) { const int n = 2 * c, hh = n >> 7, d = n & 127; const float* p = wuq + hh * 192 + d;
        dot2(cq + (size_t)row * 512, 512, p, p + 1, 3072, v0, v1);
        *(unsigned*)(Qn + (size_t)row * 2048 + n) = pk2(v0 * QS_MLA, v1 * QS_MLA);
    } else { const int ci = c - 1024, hh = ci >> 5, i = ci & 31; const float* p = wuq + hh * 192 + 128 + i;
        dot2(cq + (size_t)row * 512, 512, p, p + 32, 3072, v0, v1);
        const float2 t = cs[(size_t)row * 32 + i];
        *(unsigned*)(Qr + (size_t)row * 1024 + hh * 64 + 2 * i) = pk2((v0 * t.x - v1 * t.y) * QS_MLA, (v1 * t.x + v0 * t.y) * QS_MLA);
    }
}
__global__ void k_n_mla_ukv(const bf16_t* ckv, const float* wukv, bf16_t* Kn, bf16_t* V) {
    const int c = blockIdx.x * 256 + threadIdx.x, row = blockIdx.y;
    const int n = 2 * c, which = n >> 11, nn = n & 2047, hh = nn >> 7, d = nn & 127; const float* p = wukv + hh * 256 + which * 128 + d;
    float v0, v1; dot2(ckv + (size_t)row * 512, 512, p, p + 1, 4096, v0, v1);
    *(unsigned*)((which ? V : Kn) + (size_t)row * 2048 + nn) = pk2(v0, v1);
}
__global__ void k_n_wo(const bf16_t* O, const float* wo, float* h) {
    const int c = blockIdx.x * 256 + threadIdx.x, row = blockIdx.y;
    const int n = 2 * c; float v0, v1; dot2(O + (size_t)row * D, D, wo + n, wo + n + 1, D, v0, v1);
    float2* hp = (float2*)(h + (size_t)row * D + n); float2 x = *hp; x.x += v0; x.y += v1; *hp = x;
}
__global__ void k_n_fox_a(const bf16_t* abf, const float* wqkv, const float* wog, const float* wf, const float* bfv, bf16_t* Q, bf16_t* K, bf16_t* V, bf16_t* G, float* logf) {
    const int c = blockIdx.x * 256 + threadIdx.x, row = blockIdx.y; if (c >= 4104) return;
    const int n = 2 * c; float v0, v1; const bf16_t* a = abf + (size_t)row * D;
    if (n < 6144) { dot2(a, D, wqkv + n, wqkv + n + 1, 6144, v0, v1); bf16_t* o = (n < 2048 ? Q : (n < 4096 ? K : V)); *(unsigned*)(o + (size_t)row * 2048 + (n & 2047)) = pk2(v0, v1); }
    else if (n < 8192) { const int m = n - 6144; dot2(a, D, wog + m, wog + m + 1, 2048, v0, v1); *(unsigned*)(G + (size_t)row * 2048 + m) = pk2(1.0f / (1.0f + expf(-v0)), 1.0f / (1.0f + expf(-v1))); }
    else { const int m = n - 8192; dot2(a, D, wf + m, wf + m + 1, 16, v0, v1); v0 += bfv[m]; v1 += bfv[m + 1];
        logf[(size_t)row * 16 + m] = fminf(v0, 0.f) - log1pf(expf(-fabsf(v0))); logf[(size_t)row * 16 + m + 1] = fminf(v1, 0.f) - log1pf(expf(-fabsf(v1))); }
}
__global__ void __launch_bounds__(512) k_fox_qknorm(bf16_t* Q, bf16_t* K, const float* gq, const float* gk) {
    const int row = blockIdx.x * 8 + (threadIdx.x >> 6), lane = threadIdx.x & 63;
#pragma unroll
    for (int part = 0; part < 2; ++part) {
        bf16_t* p = (part ? K : Q) + (size_t)row * 2048 + 32 * lane; const float* g = (part ? gk : gq) + 32 * (lane & 3);
        u32x4 v[4]; float ss = 0.f;
#pragma unroll
        for (int j = 0; j < 4; ++j) { v[j] = *(const u32x4*)(p + 8 * j); const unsigned w[4] = {v[j].x, v[j].y, v[j].z, v[j].w};
#pragma unroll
            for (int e = 0; e < 4; ++e) { const float a = __uint_as_float(w[e] << 16), b = __uint_as_float(w[e] & 0xffff0000u); ss += a * a + b * b; } }
        ss += __shfl_xor(ss, 1); ss += __shfl_xor(ss, 2);
        const float sc = (1.0f / sqrtf(ss * (1.0f / 128.0f) + EPS)) * (part ? 1.0f : QS_FOX);
#pragma unroll
        for (int j = 0; j < 4; ++j) { const unsigned w[4] = {v[j].x, v[j].y, v[j].z, v[j].w}; unsigned o[4];
#pragma unroll
            for (int e = 0; e < 4; ++e) { const float a = __uint_as_float(w[e] << 16), b = __uint_as_float(w[e] & 0xffff0000u); o[e] = pk2(a * sc * g[8 * j + 2 * e], b * sc * g[8 * j + 2 * e + 1]); }
            u32x4 ov; ov.x = o[0]; ov.y = o[1]; ov.z = o[2]; ov.w = o[3]; *(u32x4*)(p + 8 * j) = ov; }
    }
}
__global__ void __launch_bounds__(64) k_fox_scan(const float* logf, float* nck) {
    const int bh = blockIdx.x, b = bh / NH, hh = bh % NH, lane = threadIdx.x;
    const float* src = logf + ((size_t)b * S + 64 * lane) * 16 + hh;
    float tot = 0.f; for (int i = 0; i < 64; ++i) tot += src[(size_t)i * 16];
    float inc = tot;
#pragma unroll
    for (int o = 1; o < 64; o <<= 1) { const float t = __shfl_up(inc, o); if (lane >= o) inc += t; }
    float run = inc - tot;
    float* dst = nck + (size_t)bh * S + 64 * lane;
    for (int i = 0; i < 64; ++i) { run += src[(size_t)i * 16]; dst[i] = -run * LOG2E; }
}

template <int MODE  >
__global__ void __launch_bounds__(512) k_nattn(const bf16_t* Qn, const bf16_t* Qr, const bf16_t* Kn, const bf16_t* Kr, const bf16_t* V, const float* nck, const bf16_t* gate, bf16_t* O) {
    __shared__ float qs[8][192];
    const int wv = threadIdx.x >> 6, lane = threadIdx.x & 63;
    const int idx = blockIdx.x * 8 + wv, s = idx % S, bh = idx / S, b = bh / NH, hh = bh % NH;
    const size_t tq = (size_t)b * S + s;
    for (int d = lane; d < 128; d += 64) qs[wv][d] = bf2f(Qn[tq * 2048 + hh * 128 + d]);
    if (MODE == 0) qs[wv][128 + lane] = bf2f(Qr[tq * 1024 + hh * 64 + lane]);
    __syncthreads();
    const int nkeys = MODE == 0 ? ((s | 63) + 1) : s + 1;
    float m = -1e30f, l = 0.f, o0 = 0.f, o1 = 0.f;
    for (int base = 0; base < nkeys; base += 64) {
        const int j = base + lane; const bool valid = j < nkeys;
        float dot = -__builtin_inff();
        if (valid) {
            const size_t tk = (size_t)b * S + j;
            const u32x4* kp = (const u32x4*)(Kn + tk * 2048 + hh * 128);
            dot = 0.f;
#pragma unroll
            for (int c = 0; c < 16; ++c) { const u32x4 kv = kp[c]; const unsigned w[4] = {kv.x, kv.y, kv.z, kv.w};
#pragma unroll
                for (int e = 0; e < 4; ++e) dot += qs[wv][8 * c + 2 * e] * __uint_as_float(w[e] << 16) + qs[wv][8 * c + 2 * e + 1] * __uint_as_float(w[e] & 0xffff0000u); }
            if (MODE == 0) { const u32x4* rp = (const u32x4*)(Kr + tk * 64);
#pragma unroll
                for (int c = 0; c < 8; ++c) { const u32x4 kv = rp[c]; const unsigned w[4] = {kv.x, kv.y, kv.z, kv.w};
#pragma unroll
                    for (int e = 0; e < 4; ++e) dot += qs[wv][128 + 8 * c + 2 * e] * __uint_as_float(w[e] << 16) + qs[wv][128 + 8 * c + 2 * e + 1] * __uint_as_float(w[e] & 0xffff0000u); } }
            if (MODE == 1) dot += nck[(size_t)bh * S + j];
        }
        const float mn = fmaxf(m, wave_max(dot)), alpha = exp2f(m - mn), p = valid ? exp2f(dot - mn) : 0.f;
        l = l * alpha + p; o0 *= alpha; o1 *= alpha; m = mn;
        const int nk = (nkeys - base) < 64 ? (nkeys - base) : 64;
        const bf16_t* vb = V + ((size_t)b * S + base) * 2048 + hh * 128 + lane;
        for (int jj = 0; jj < nk; ++jj) { const float pj = __shfl(p, jj); o0 += pj * bf2f(vb[(size_t)jj * 2048]); o1 += pj * bf2f(vb[(size_t)jj * 2048 + 64]); }
    }
    const float inv = 1.0f / wave_sum(l);
    float g0 = 1.f, g1 = 1.f;
    if (MODE == 1) { g0 = bf2f(gate[tq * 2048 + hh * 128 + lane]); g1 = bf2f(gate[tq * 2048 + hh * 128 + 64 + lane]); }
    O[tq * 2048 + hh * 128 + lane] = (bf16_t)f2bf(o0 * inv * g0);
    O[tq * 2048 + hh * 128 + 64 + lane] = (bf16_t)f2bf(o1 * inv * g1);
}

__global__ void __launch_bounds__(512) k_n_router(const float* h, const float* gain, const float* wg, const float* bg, const float* wr, const float* br,
                                                   bf16_t* abf, unsigned* cnt, int* rowlist, float* roww) {
    const int row = blockIdx.x * 8 + (threadIdx.x >> 6), lane = threadIdx.x & 63;
    const f32x4* s4 = (const f32x4*)(h + (size_t)row * D) + lane; const f32x4* g4 = (const f32x4*)gain + lane;
    f32x4 v[8]; float ss = 0.f;
#pragma unroll
    for (int j = 0; j < 8; ++j) { v[j] = s4[64 * j]; ss += (v[j][0] * v[j][0] + v[j][1] * v[j][1]) + (v[j][2] * v[j][2] + v[j][3] * v[j][3]); }
    const float rstd = 1.0f / sqrtf(wave_sum(ss) * (1.0f / D) + EPS);
    u32x2* a2 = (u32x2*)(abf + (size_t)row * D) + lane;
#pragma unroll
    for (int j = 0; j < 8; ++j) { v[j] = v[j] * rstd * g4[64 * j]; u32x2 w; w.x = pk2(v[j][0], v[j][1]); w.y = pk2(v[j][2], v[j][3]); a2[64 * j] = w; }
    float lg[40];
#pragma unroll
    for (int c = 0; c < 40; ++c) lg[c] = 0.f;
#pragma unroll
    for (int j = 0; j < 8; ++j)
#pragma unroll
        for (int e = 0; e < 4; ++e) { const int k = 4 * lane + 256 * j + e; const float x = v[j][e];
            const f32x4* pg = (const f32x4*)(wg + (size_t)k * 8); const f32x4* pr = (const f32x4*)(wr + (size_t)k * 32);
#pragma unroll
            for (int q = 0; q < 2; ++q) { const f32x4 w = pg[q]; lg[4 * q] += x * w[0]; lg[4 * q + 1] += x * w[1]; lg[4 * q + 2] += x * w[2]; lg[4 * q + 3] += x * w[3]; }
#pragma unroll
            for (int q = 0; q < 8; ++q) { const f32x4 w = pr[q]; lg[8 + 4 * q] += x * w[0]; lg[8 + 4 * q + 1] += x * w[1]; lg[8 + 4 * q + 2] += x * w[2]; lg[8 + 4 * q + 3] += x * w[3]; } }
#pragma unroll
    for (int c = 0; c < 40; ++c) lg[c] = wave_sum(lg[c]);
    float gl[8]; float gmax = -3.0e38f; int gs = 0;
#pragma unroll
    for (int c = 0; c < 8; ++c) { gl[c] = lg[c] + bg[c]; if (gl[c] > gmax) { gmax = gl[c]; gs = c; } }
    float gsum = 0.f;
#pragma unroll
    for (int c = 0; c < 8; ++c) gsum += expf(gl[c] - gmax);
    const float gw = 1.0f / gsum;
    float el[4];
#pragma unroll
    for (int j = 0; j < 4; ++j) { float x = 0.f;
#pragma unroll
        for (int g = 0; g < 8; ++g) x = (g == gs) ? lg[8 + 4 * g + j] + br[4 * g + j] : x;
        el[j] = x; }
    int j1 = 0; float m1 = el[0];
#pragma unroll
    for (int j = 1; j < 4; ++j) if (el[j] > m1) { m1 = el[j]; j1 = j; }
    int j2 = -1; float m2 = -3.0e38f;
#pragma unroll
    for (int j = 0; j < 4; ++j) if (j != j1 && el[j] > m2) { m2 = el[j]; j2 = j; }
    const float e2 = expf(m2 - m1), w1 = gw / (1.0f + e2), w2 = gw * e2 / (1.0f + e2);
    if (lane < 2) { const int e = gs * 4 + (lane == 0 ? j1 : j2); const float w = lane == 0 ? w1 : w2;
        const unsigned r = atomicAdd(cnt + e, 1u); rowlist[e * ECAP + r] = row * 2 + lane; roww[e * ECAP + r] = w; }
}
__device__ __forceinline__ bool moe_locate(const unsigned* cnt, int gr, int& e, int& r) {
    int off = 0;
    for (int i = 0; i < NE; ++i) { const int c = (int)cnt[i], p = (c + 255) & ~255; if (gr < off + p) { e = i; r = gr - off; return r < c; } off += p; }
    e = 0; r = 0; return false;
}
__global__ void k_n_moe_gu(const bf16_t* abf, const float* wgate, const float* wup, const unsigned* cnt, const int* rowlist, bf16_t* hid) {
    const int c = blockIdx.y * 256 + threadIdx.x, gr = blockIdx.x;
    int e, r; if (!moe_locate(cnt, gr, e, r)) return;
    const int tok = rowlist[e * ECAP + r] >> 1;
    float v0, v1; dot2(abf + (size_t)tok * D, D, wgate + (size_t)e * D * FF + c, wup + (size_t)e * D * FF + c, FF, v0, v1);
    hid[(size_t)gr * FF + c] = (bf16_t)f2bf(v0 / (1.0f + expf(-v0)) * v1);
}
__global__ void k_n_moe_d(const bf16_t* hid, const float* wdown, const unsigned* cnt, const int* rowlist, const float* roww, bf16_t* y2) {
    const int c = blockIdx.y * 256 + threadIdx.x, gr = blockIdx.x;
    int e, r; if (!moe_locate(cnt, gr, e, r)) return;
    const int dst = rowlist[e * ECAP + r]; const float w = roww[e * ECAP + r];
    const int n = 2 * c; float v0, v1; dot2(hid + (size_t)gr * FF, FF, wdown + (size_t)e * FF * D + n, wdown + (size_t)e * FF * D + n + 1, D, v0, v1);
    *(unsigned*)(y2 + (size_t)dst * D + n) = pk2(v0 * w, v1 * w);
}

#define LAS __attribute__((address_space(3)))
#define GAS __attribute__((address_space(1)))
typedef short bf16x8 __attribute__((ext_vector_type(8)));
typedef GAS unsigned gu32;
#define RLX_AGENT __ATOMIC_RELAXED, __HIP_MEMORY_SCOPE_AGENT
#define LDS_WAIT() asm volatile("s_waitcnt lgkmcnt(0)" ::: "memory")
#define VM_WAIT() asm volatile("s_waitcnt vmcnt(0)" ::: "memory")

constexpr size_t WS_W_MLA_A = 32 * MiB;
constexpr size_t WS_W_MLA_UQ = 42 * MiB;
constexpr size_t WS_W_MLA_UKV = 48 * MiB;
constexpr size_t WS_W_MLA_O = 56 * MiB;
constexpr size_t WS_W_FOX_A = 72 * MiB;
constexpr size_t WS_W_FOX_O = 138 * MiB;
constexpr size_t WS_W_GU = 154 * MiB;
constexpr size_t WS_W_D = 666 * MiB;
static_assert(WS_W_D + 128ull * 2048 * 512 * 2 <= WS_ABF, "weights map");
constexpr int CW_BAR = 4096;
constexpr int CW_TMO = 0;

constexpr int LDS_CTL_BYTES = 1024;
constexpr int RING_OFF = 1024, RING_BYTES = 131072;
constexpr int LDS_BYTES = 147456;

namespace pg8 {
constexpr int BM = 256, BK = 64, HALF = 128, HTB = HALF * BK * 2, STAGE_BYTES = 8 * HTB, NXCD = 8, WGM = 8;
__host__ __device__ __forceinline__ int lds_byte(int r, int c) { const int st = (r >> 4) * 2 + (c >> 5), rr = r & 15, cc = c & 31, ob = rr * 64 + cc * 2; return st * 1024 + (ob ^ (((ob >> 9) & 1) << 5)); }
__host__ __device__ __forceinline__ void stage_rc(int b, int& R, int& C) { const int st = b / 1024, sb = b % 1024, swz = sb ^ (((sb >> 9) & 1) << 5); R = (st >> 1) * 16 + swz / 64; C = (st & 1) * 32 + (swz % 64) / 2; }
__host__ __device__ __forceinline__ int perm32(int rho) { const int n = rho >> 4, i = rho & 15; return 8 * (i >> 2) + 4 * n + (i & 3); }

struct Unit { int pm, pn, e, r0; };
struct Gemm { const bf16_t* A; const bf16_t* Bt; int K; size_t bstride_e; };

struct StaticOrder {
    int nM, nN, nwg, G, c;
    __device__ void init(int M, int N, int G_, int c_) { nM = M / BM; nN = N / BM; nwg = nM * nN; G = G_; c = c_; }
    __device__ bool next(int i, Unit& u) const {
        const long L = (long)i * G + c; if (L >= nwg) return false;
        int wgid = (int)L; { const int q = nwg / NXCD, r = nwg % NXCD, xcd = wgid % NXCD, off = wgid / NXCD; wgid = (xcd < r ? xcd * (q + 1) : r * (q + 1) + (xcd - r) * q) + off; }
        const int nig = WGM * nN, gid = wgid / nig, fm = gid * WGM, gsz = (nM - fm) < WGM ? (nM - fm) : WGM;
        u.pm = fm + ((wgid % nig) % gsz); u.pn = (wgid % nig) / gsz; u.e = 0; u.r0 = 0; return true;
    }
    __device__ __forceinline__ void gather(const Unit&, unsigned (&)[2][2], const int (&)[2], const int (&)[2], int) const {}
};
struct MoeOrder {
    const LAS int* pre;
    const int* rowlist; const unsigned* cnt; int nN, nU, G, c;
    __device__ void init(const LAS int* pre_, const int* rl, const unsigned* cnt_, int nN_, int G_, int c_) { pre = pre_; rowlist = rl; cnt = cnt_; nN = nN_; nU = pre_[NE] * nN_; G = G_; c = c_; }
    __device__ bool next(int i, Unit& u) const {
        const int perX = (nU + NXCD - 1) / NXCD, x = c % NXCD, k = i * (G / NXCD) + c / NXCD;
        if (k >= perX) return false; const int L = x * perX + k; if (L >= nU) return false;
        const int g = L / nN; u.pn = L - g * nN; int e = 0;
#pragma unroll 1
        for (int j = 16; j >= 1; j >>= 1) if (pre[e + j] <= g) e += j;
        u.e = e; u.pm = g; u.r0 = (g - pre[e]) * BM; return true;
    }
    __device__ __forceinline__ void gather(const Unit& u, unsigned (&v)[2][2], const int (&R)[2], const int (&C)[2], int K) const {
        const int n = (int)cnt[u.e];
#pragma unroll
        for (int h = 0; h < 2; ++h)
#pragma unroll
            for (int i = 0; i < 2; ++i) { const int r = u.r0 + h * HALF + R[i]; const int tok = r < n ? (rowlist[u.e * ECAP + r] >> 1) : 0; v[h][i] = (unsigned)(tok * K + C[i]) * 2u; }
    }
};

__device__ __forceinline__ unsigned cvt_pk_bf16(float lo, float hi) { unsigned r; asm volatile("v_cvt_pk_bf16_f32 %0, %1, %2" : "=v"(r) : "v"(lo), "v"(hi)); return r; }
__device__ __forceinline__ float fsigmoid(float x) { return __builtin_amdgcn_rcpf(1.0f + __builtin_amdgcn_exp2f(-x * LOG2E)); }

typedef const f32x4 (&AccRef)[2][2][4][2];
#define EPI_ROWS(ai, m) (u.pm * BM + (ai) * HALF + wr * 64 + (m) * 16 + fr)
__device__ __forceinline__ u32x4 pack8s(f32x4 a, f32x4 b, float s) { u32x4 w; w.x = cvt_pk_bf16(a[0] * s, a[1] * s); w.y = cvt_pk_bf16(a[2] * s, a[3] * s); w.z = cvt_pk_bf16(b[0] * s, b[1] * s); w.w = cvt_pk_bf16(b[2] * s, b[3] * s); return w; }

struct EpiBf16S {
    static constexpr bool PERM = true;
    bf16_t* O; int ldc; int split_cols; size_t split_stride; float scale;
    __device__ __forceinline__ void operator()(AccRef acc, const Unit& u, int wr, int wc, int fr, int fq) const {
        int colt = u.pn * BM; bf16_t* base = O; if (split_cols) { const int t = colt / split_cols; base += (size_t)t * split_stride; colt -= t * split_cols; }
        const int col0 = colt + wc * 32 + 8 * fq;
#pragma unroll
        for (int ai = 0; ai < 2; ++ai)
#pragma unroll
            for (int m = 0; m < 4; ++m) { bf16_t* rowp = base + (size_t)EPI_ROWS(ai, m) * ldc + col0;
#pragma unroll
                for (int bj = 0; bj < 2; ++bj) *(u32x4*)(rowp + bj * HALF) = pack8s(acc[ai][bj][m][0], acc[ai][bj][m][1], scale); }
    }
};
struct EpiMlaQ {
    static constexpr bool PERM = true;
    bf16_t* Qn; bf16_t* Qr; const float* cs;
    __device__ __forceinline__ void operator()(AccRef acc, const Unit& u, int wr, int wc, int fr, int fq) const {
        if (u.pn < 8) { const int col0 = u.pn * BM + wc * 32 + 8 * fq;
#pragma unroll
            for (int ai = 0; ai < 2; ++ai)
#pragma unroll
                for (int m = 0; m < 4; ++m) { bf16_t* rowp = Qn + (size_t)EPI_ROWS(ai, m) * 2048 + col0;
#pragma unroll
                    for (int bj = 0; bj < 2; ++bj) *(u32x4*)(rowp + bj * HALF) = pack8s(acc[ai][bj][m][0], acc[ai][bj][m][1], QS_MLA); }
        } else { const int col0 = (u.pn - 8) * BM + wc * 32 + 8 * fq;
#pragma unroll
            for (int ai = 0; ai < 2; ++ai)
#pragma unroll
                for (int m = 0; m < 4; ++m) { const int row = EPI_ROWS(ai, m); bf16_t* rowp = Qr + (size_t)row * 1024 + col0;
#pragma unroll
                    for (int bj = 0; bj < 2; ++bj) { const int i0 = ((col0 + bj * HALF) & 63) >> 1; const f32x4* cp = (const f32x4*)(cs + ((size_t)row * 32 + i0) * 2);
                        const f32x4 ca = cp[0], cb = cp[1], a = acc[ai][bj][m][0], b = acc[ai][bj][m][1]; f32x4 ra, rb;
                        ra[0] = a[0] * ca[0] - a[1] * ca[1]; ra[1] = a[1] * ca[0] + a[0] * ca[1]; ra[2] = a[2] * ca[2] - a[3] * ca[3]; ra[3] = a[3] * ca[2] + a[2] * ca[3];
                        rb[0] = b[0] * cb[0] - b[1] * cb[1]; rb[1] = b[1] * cb[0] + b[0] * cb[1]; rb[2] = b[2] * cb[2] - b[3] * cb[3]; rb[3] = b[3] * cb[2] + b[2] * cb[3];
                        *(u32x4*)(rowp + bj * HALF) = pack8s(ra, rb, QS_MLA); } }
        }
    }
};
struct EpiFoxA {
    static constexpr bool PERM = true;
    bf16_t* O; size_t stride; float* logf; const float* bfv;
    __device__ __forceinline__ void operator()(AccRef acc, const Unit& u, int wr, int wc, int fr, int fq) const {
        if (u.pn < 32) { const int t = u.pn >> 3; bf16_t* base = O + (size_t)t * stride; const int col0 = (u.pn & 7) * BM + wc * 32 + 8 * fq; const bool sg = t == 3;
#pragma unroll
            for (int ai = 0; ai < 2; ++ai)
#pragma unroll
                for (int m = 0; m < 4; ++m) { bf16_t* rowp = base + (size_t)EPI_ROWS(ai, m) * 2048 + col0;
#pragma unroll
                    for (int bj = 0; bj < 2; ++bj) { f32x4 a = acc[ai][bj][m][0], b = acc[ai][bj][m][1];
                        if (sg) {
#pragma unroll
                            for (int e = 0; e < 4; ++e) { a[e] = fsigmoid(a[e]); b[e] = fsigmoid(b[e]); } }
                        *(u32x4*)(rowp + bj * HALF) = pack8s(a, b, 1.0f); } }
        } else if (wc == 0 && fq < 2) {
#pragma unroll
            for (int ai = 0; ai < 2; ++ai)
#pragma unroll
                for (int m = 0; m < 4; ++m) { float* rowp = logf + (size_t)EPI_ROWS(ai, m) * 16 + 8 * fq;
#pragma unroll
                    for (int n = 0; n < 2; ++n) { f32x4 a = acc[ai][0][m][n]; const f32x4 bb = *(const f32x4*)(bfv + 8 * fq + 4 * n);
#pragma unroll
                        for (int e = 0; e < 4; ++e) { const float x = a[e] + bb[e]; a[e] = fminf(x, 0.f) - log1pf(expf(-fabsf(x))); }
                        *(f32x4*)(rowp + 4 * n) = a; } }
        }
    }
};
struct EpiRes {
    static constexpr bool PERM = true;
    float* h;
    __device__ __forceinline__ void operator()(AccRef acc, const Unit& u, int wr, int wc, int fr, int fq) const {
        const int col0 = u.pn * BM + wc * 32 + 8 * fq;
#pragma unroll
        for (int ai = 0; ai < 2; ++ai)
#pragma unroll
            for (int m = 0; m < 4; ++m) { float* rowp = h + (size_t)EPI_ROWS(ai, m) * D + col0;
#pragma unroll
                for (int bj = 0; bj < 2; ++bj) { f32x4* p = (f32x4*)(rowp + bj * HALF); p[0] = p[0] + acc[ai][bj][m][0]; p[1] = p[1] + acc[ai][bj][m][1]; } }
    }
};
struct EpiGU {
    static constexpr bool PERM = true;
    bf16_t* hid;
    __device__ __forceinline__ void operator()(AccRef acc, const Unit& u, int wr, int wc, int fr, int fq) const {
        const int col0 = u.pn * HALF + wc * 32 + 8 * fq;
#pragma unroll
        for (int ai = 0; ai < 2; ++ai)
#pragma unroll
            for (int m = 0; m < 4; ++m) { f32x4 o[2];
#pragma unroll
                for (int n = 0; n < 2; ++n)
#pragma unroll
                    for (int e = 0; e < 4; ++e) { const float g = acc[ai][0][m][n][e]; o[n][e] = g * fsigmoid(g) * acc[ai][1][m][n][e]; }
                *(u32x4*)(hid + (size_t)EPI_ROWS(ai, m) * FF + col0) = pack8s(o[0], o[1], 1.0f); }
    }
};
struct EpiDown {
    static constexpr bool PERM = true;
    bf16_t* y2; const int* rowlist; const float* roww; const unsigned* cnt;
    __device__ __forceinline__ void operator()(AccRef acc, const Unit& u, int wr, int wc, int fr, int fq) const {
        const int col0 = u.pn * BM + wc * 32 + 8 * fq, n = (int)cnt[u.e];
#pragma unroll
        for (int ai = 0; ai < 2; ++ai)
#pragma unroll
            for (int m = 0; m < 4; ++m) { const int r = u.r0 + ai * HALF + wr * 64 + m * 16 + fr;
                if (r < n) { const int dst = rowlist[u.e * ECAP + r]; const float w = roww[u.e * ECAP + r]; bf16_t* rowp = y2 + (size_t)dst * D + col0;
#pragma unroll
                    for (int bj = 0; bj < 2; ++bj) *(u32x4*)(rowp + bj * HALF) = pack8s(acc[ai][bj][m][0], acc[ai][bj][m][1], w); } }
    }
};

template <class Epi, class Sched, bool GATHER>
__device__ __forceinline__ void gemm_phase(LAS unsigned char* lds, const Gemm g, const Sched& S, const Epi& E) {
    int tid = threadIdx.x; asm volatile("" : "+v"(tid));
    const int wid = __builtin_amdgcn_readfirstlane(tid >> 6), lane = tid & 63, wr = wid >> 2, wc = wid & 3, fr = lane & 15, fq = lane >> 4;
    const int K = g.K, nt = K / BK;
    int sR[2], sC[2]; unsigned voffB[2], vA[2][2], vAn[2][2];
#pragma unroll
    for (int i = 0; i < 2; ++i) { stage_rc(tid * 16 + i * 8192, sR[i], sC[i]); const int Rb = Epi::PERM ? ((sR[i] & ~31) + perm32(sR[i] & 31)) : sR[i];
        voffB[i] = (unsigned)(Rb * K + sC[i]) * 2u;
#pragma unroll
        for (int h = 0; h < 2; ++h) { vA[h][i] = (unsigned)((h * HALF + sR[i]) * K + sC[i]) * 2u; vAn[h][i] = vA[h][i]; } }
    const size_t kstep = (size_t)(BK * 2), hstep = (size_t)HALF * K * 2, tstep = 2 * hstep;
    const unsigned ldsw = (unsigned)wid * 1024u;
    const int aoff = lds_byte(wr * 64 + fr, fq * 8), boff = lds_byte(wc * 32 + fr, fq * 8);
#define PG8_SA(b, h) (((b) * 2 + (h)) * HTB)
#define PG8_SB(b, h) ((4 + (b) * 2 + (h)) * HTB)
#define PG8_STAGE(bufoff, gbase, voff) do { _Pragma("unroll") for (int _i = 0; _i < 2; ++_i) \
        __builtin_amdgcn_global_load_lds((const unsigned*)((const char*)(gbase) + (voff)[_i]), (LAS unsigned*)(lds + (bufoff) + ldsw + _i * 8192), 16, 0, 0); } while (0)
#define PG8_LDA(dst, b, h) do { _Pragma("unroll") for (int m = 0; m < 4; ++m) _Pragma("unroll") for (int k = 0; k < 2; ++k) dst[m][k] = *(const LAS bf16x8*)(lds + PG8_SA(b, h) + aoff + m * 2048 + k * 1024); } while (0)
#define PG8_LDB(dst, b, h) do { _Pragma("unroll") for (int n = 0; n < 2; ++n) _Pragma("unroll") for (int k = 0; k < 2; ++k) dst[n][k] = *(const LAS bf16x8*)(lds + PG8_SB(b, h) + boff + n * 2048 + k * 1024); } while (0)
#define PG8_MMA(ai, bj, At, Bt) do { __builtin_amdgcn_s_setprio(1); _Pragma("unroll") for (int m = 0; m < 4; ++m) _Pragma("unroll") for (int n = 0; n < 2; ++n) _Pragma("unroll") for (int k = 0; k < 2; ++k) \
        acc[ai][bj][m][n] = __builtin_amdgcn_mfma_f32_16x16x32_bf16(Bt[n][k], At[m][k], acc[ai][bj][m][n], 0, 0, 0); __builtin_amdgcn_s_setprio(0); } while (0)
#define PG8_WAIT_V(n) asm volatile("s_waitcnt vmcnt(" #n ")" ::: "memory")
#define PG8_WAIT_L(n) asm volatile("s_waitcnt lgkmcnt(" #n ")" ::: "memory")
#define PG8_BAR __builtin_amdgcn_s_barrier()
#define PG8_SCHED __builtin_amdgcn_sched_barrier(0)
    Unit cur, nxt; int ui = 0;
    if (!S.next(0, cur)) return;
    f32x4 acc[2][2][4][2];
#pragma unroll
    for (int a = 0; a < 2; ++a)
#pragma unroll
        for (int b = 0; b < 2; ++b)
#pragma unroll
            for (int m = 0; m < 4; ++m)
#pragma unroll
                for (int n = 0; n < 2; ++n) acc[a][b][m][n] = (f32x4){0.f, 0.f, 0.f, 0.f};
    bf16x8 At[4][2], B0[2][2], B1[2][2];
    const char* cA = GATHER ? (const char*)g.A : (const char*)g.A + (size_t)cur.pm * tstep;
    const char* cB = (const char*)g.Bt + ((size_t)cur.e * g.bstride_e) * 2 + (size_t)cur.pn * tstep;
    if (GATHER) S.gather(cur, vA, sR, sC, K);
    PG8_STAGE(PG8_SB(0, 0), cB, voffB); PG8_STAGE(PG8_SB(0, 1), cB + hstep, voffB); PG8_STAGE(PG8_SA(0, 0), cA, vA[0]); PG8_STAGE(PG8_SA(0, 1), cA, vA[1]);
    if (wr == 1) PG8_BAR;
    PG8_WAIT_V(2); PG8_BAR;
    PG8_STAGE(PG8_SB(1, 0), cB + kstep, voffB); PG8_STAGE(PG8_SA(1, 0), cA + kstep, vA[0]); PG8_STAGE(PG8_SB(1, 1), cB + hstep + kstep, voffB);
    PG8_WAIT_V(6); PG8_BAR;
    for (;;) {
        const bool has_next = S.next(ui + 1, nxt);
        const char* nA = has_next ? (GATHER ? (const char*)g.A : (const char*)g.A + (size_t)nxt.pm * tstep) : cA;
        const char* nB = has_next ? (const char*)g.Bt + ((size_t)nxt.e * g.bstride_e) * 2 + (size_t)nxt.pn * tstep : cB;
        if (GATHER) { if (has_next) S.gather(nxt, vAn, sR, sC, K); else {
#pragma unroll
            for (int h = 0; h < 2; ++h)
#pragma unroll
                for (int i = 0; i < 2; ++i) vAn[h][i] = vA[h][i]; } }
        for (int t = 0; t < nt; t += 2) {
            const bool last = (t == nt - 2);
            const char* a1 = cA + (size_t)(t + 1) * kstep;
            const char* a2 = last ? nA : cA + (size_t)(t + 2) * kstep; const char* b2 = last ? nB : cB + (size_t)(t + 2) * kstep;
            const char* a3 = a2 + kstep; const char* b3 = b2 + kstep;
            unsigned vs[2][2];
#pragma unroll
            for (int h = 0; h < 2; ++h)
#pragma unroll
                for (int i = 0; i < 2; ++i) vs[h][i] = (GATHER && last) ? vAn[h][i] : vA[h][i];
            PG8_LDB(B0, 0, 0); PG8_LDB(B1, 0, 1); PG8_SCHED; PG8_LDA(At, 0, 0); PG8_STAGE(PG8_SA(1, 1), a1, vA[1]);
            PG8_WAIT_V(8); PG8_WAIT_L(0); PG8_BAR; PG8_MMA(0, 0, At, B0); PG8_MMA(0, 1, At, B1); PG8_BAR; PG8_SCHED;
            PG8_LDA(At, 0, 1); PG8_STAGE(PG8_SB(0, 0), b2, voffB); PG8_STAGE(PG8_SB(0, 1), b2 + hstep, voffB); PG8_STAGE(PG8_SA(0, 0), a2, vs[0]);
            PG8_WAIT_V(8); PG8_WAIT_L(0); PG8_BAR; PG8_MMA(1, 0, At, B0); PG8_MMA(1, 1, At, B1); PG8_BAR; PG8_SCHED;
            PG8_LDB(B0, 1, 0); PG8_LDB(B1, 1, 1); PG8_SCHED; PG8_LDA(At, 1, 0); PG8_STAGE(PG8_SA(0, 1), a2, vs[1]);
            PG8_WAIT_V(8); PG8_WAIT_L(0); PG8_BAR; PG8_MMA(0, 0, At, B0); PG8_MMA(0, 1, At, B1); PG8_BAR; PG8_SCHED;
            PG8_LDA(At, 1, 1); PG8_STAGE(PG8_SB(1, 0), b3, voffB); PG8_STAGE(PG8_SB(1, 1), b3 + hstep, voffB); PG8_STAGE(PG8_SA(1, 0), a3, vs[0]);
            PG8_WAIT_V(8); PG8_WAIT_L(0); PG8_BAR; PG8_MMA(1, 0, At, B0); PG8_MMA(1, 1, At, B1); PG8_BAR; PG8_SCHED;
        }
        if (wr == 0) PG8_BAR;
        E(acc, cur, wr, wc, fr, fq);
        if (!has_next) break;
#pragma unroll
        for (int a = 0; a < 2; ++a)
#pragma unroll
            for (int b = 0; b < 2; ++b)
#pragma unroll
                for (int m = 0; m < 4; ++m)
#pragma unroll
                    for (int n = 0; n < 2; ++n) acc[a][b][m][n] = (f32x4){0.f, 0.f, 0.f, 0.f};
        cur = nxt; cA = nA; cB = nB; ++ui;
        if (GATHER) {
#pragma unroll
            for (int h = 0; h < 2; ++h)
#pragma unroll
                for (int i = 0; i < 2; ++i) vA[h][i] = vAn[h][i]; }
        if (wr == 1) PG8_BAR;
    }
    PG8_WAIT_V(0);
    PG8_BAR;
#undef PG8_SA
#undef PG8_SB
#undef PG8_STAGE
#undef PG8_LDA
#undef PG8_LDB
#undef PG8_MMA
#undef PG8_WAIT_V
#undef PG8_WAIT_L
#undef PG8_BAR
#undef PG8_SCHED
}
}

#define XB_TMO      128
#define XB_XCNT(j)  (256  + 64 * (j))
#define XB_XSUB(j)  (1280 + 64 * (j))
#define XB_XGEN(j)  (2304 + 64 * (j))
#define XB_TOP      3328
#define XB_TOPGEN   3392
#define XCD_BAR_WORDS 3456
#define XB_SPIN_CAP (1u << 18)
__device__ __forceinline__ unsigned xb_ld(unsigned* p)              { return __hip_atomic_load(p, __ATOMIC_RELAXED, __HIP_MEMORY_SCOPE_AGENT); }
__device__ __forceinline__ unsigned xb_add(unsigned* p, unsigned v) { return __hip_atomic_fetch_add(p, v, __ATOMIC_RELAXED, __HIP_MEMORY_SCOPE_AGENT); }
__device__ __forceinline__ unsigned xb_xcc_id() { return (unsigned)__builtin_amdgcn_s_getreg((3 << 11) | 20) & 0xFu; }
#define XB_SPIN(cond, bar) do { unsigned _sp = 0; while (cond) { __builtin_amdgcn_s_sleep(1); \
    if ((++_sp & 255u) == 0u) { if (xb_ld(&(bar)[XB_TMO])) break; if (_sp > XB_SPIN_CAP) { atomicAdd(&(bar)[XB_TMO], 1u); break; } } } } while (0)
struct XcdBarrier { unsigned* bar; unsigned x; volatile LAS unsigned* st; };
__device__ __forceinline__ XcdBarrier xcd_barrier_post(unsigned* bar, volatile LAS unsigned* st) {
    XcdBarrier b; b.bar = bar; b.x = xb_xcc_id(); b.st = st;
    if (threadIdx.x == 0) (void)xb_add(&bar[XB_XCNT(b.x)], 1u);
    return b;
}
__device__ __forceinline__ void xcd_barrier_complete(unsigned* bar, unsigned x, unsigned& nloc, unsigned& nx) {
    const unsigned G = gridDim.x * gridDim.y * gridDim.z;
    unsigned sum, cnt, mine, sp = 0u;
    for (;;) {
        sum = 0u; cnt = 0u; mine = 0u;
#pragma unroll
        for (unsigned j = 0; j < 16; ++j) { const unsigned c = xb_ld(&bar[XB_XCNT(j)]); sum += c; cnt += (c > 0u) ? 1u : 0u; mine = (j == x) ? c : mine; }
        if (sum == G) break;
        __builtin_amdgcn_s_sleep(1);
        if ((++sp & 255u) == 0u) { if (xb_ld(&bar[XB_TMO])) break; if (sp > XB_SPIN_CAP) { atomicAdd(&bar[XB_TMO], 1u); break; } }
    }
    nloc = mine > 0u ? mine : 1u; nx = cnt > 0u ? cnt : 1u;
}
__device__ __forceinline__ void xcd_barrier(const XcdBarrier& b) {
    asm volatile("s_waitcnt vmcnt(0)" ::: "memory");
    __syncthreads();
    if (threadIdx.x == 0) {
        unsigned* bar = b.bar;
        __builtin_amdgcn_s_waitcnt(0);
        unsigned nloc = b.st[0], nx = b.st[1];
        if (nloc == 0u) { xcd_barrier_complete(bar, b.x, nloc, nx); b.st[0] = nloc; b.st[1] = nx; }
        const unsigned old = xb_add(&bar[XB_XSUB(b.x)], 1u);
        const unsigned gen = old / nloc;
        if (old + 1u == (gen + 1u) * nloc) {
            __builtin_amdgcn_fence(__ATOMIC_RELEASE, "agent");
            asm volatile("s_waitcnt vmcnt(0)" ::: "memory");
            const unsigned og = xb_add(&bar[XB_TOP], 1u);
            const unsigned tg = og / nx;
            if (og + 1u == (tg + 1u) * nx) xb_add(&bar[XB_TOPGEN], 1u);
            else XB_SPIN(xb_ld(&bar[XB_TOPGEN]) == tg, bar);
            __builtin_amdgcn_fence(__ATOMIC_ACQUIRE, "agent");
            xb_add(&bar[XB_XGEN(b.x)], 1u);
            asm volatile("s_waitcnt vmcnt(0)" ::: "memory");
        } else {
            XB_SPIN(xb_ld(&bar[XB_XGEN(b.x)]) == gen, bar);
            __builtin_amdgcn_fence(__ATOMIC_ACQUIRE, "agent");
            asm volatile("s_waitcnt vmcnt(0)" ::: "memory");
        }
    }
    __syncthreads();
}

namespace att {
constexpr int NW = 8, QBLK = 32, KVBLK = 64, QB = 256, PITCH = 2048;
constexpr int SHM_V = 16384, SHM_K = 16384, SHM_KR = 8192, SHM_NCK = 16384;
constexpr int OFF_K = 2 * SHM_V, OFF_WS = OFF_K + 2 * SHM_K, OFF_X = OFF_WS + 2048;
constexpr int OFF_QR = OFF_X + 2 * SHM_KR;
constexpr int LDS_NEED = OFF_QR + 8 * 4096;
static_assert(LDS_NEED <= RING_BYTES, "attention LDS");
constexpr float THR2 = 11.5f;
typedef float f32x16 __attribute__((ext_vector_type(16)));
typedef short s16x4 __attribute__((ext_vector_type(4)));
typedef LAS char* lptr;

#define KSWZ(row, colB) ((row) * 256 + ((colB) ^ (((row) & 7) << 4)))
#define KRSWZ(row, colB) ((row) * 128 + ((colB) ^ (((row) & 7) << 4)))
#define SBAR() __builtin_amdgcn_sched_barrier(0)
__device__ __forceinline__ int v_st(int k, int c) { const int kk = (k & ~0xC) | ((k & 4) << 1) | ((k & 8) >> 1); return ((kk >> 3) * 4 + (c >> 5)) * 512 + ((kk & 7) * 32 + (c & 31)) * 2; }
__device__ __forceinline__ int v_rd_base(int lane) { return ((lane & 3) << 3) | (((lane >> 2) & 3) << 6) | (((lane >> 4) & 1) << 5) | (((lane >> 5) & 1) << 8); }
constexpr int v_rd_off(int d0, int ks, int half) { return d0 * 512 + ks * 4096 + half * 2048; }
__device__ __forceinline__ int crow(int r, int hi) { return (r & 3) + 8 * (r >> 2) + 4 * hi; }
__device__ __forceinline__ unsigned cvtpk(float lo, float hi) { unsigned r; asm volatile("v_cvt_pk_bf16_f32 %0, %1, %2" : "=v"(r) : "v"(lo), "v"(hi)); return r; }
__device__ __forceinline__ void glds16(const void* gsrc, unsigned lds_dst) { unsigned keep;
    asm volatile("s_mov_b32 %0, m0\n\ts_mov_b32 m0, %2\n\ts_nop 0\n\tglobal_load_lds_dwordx4 %1, off\n\ts_mov_b32 m0, %0" : "=&s"(keep) : "v"(gsrc), "s"(lds_dst) : "memory"); }
__device__ __forceinline__ void mask_tile(f32x16& p0, f32x16& p1, int dq) {
    const float NEG = -__builtin_inff();
#pragma unroll
    for (int r = 0; r < 16; ++r) { const int c = (r & 3) + 8 * (r >> 2); if (dq - c < 0) p0[r] = NEG; if (dq - c - 32 < 0) p1[r] = NEG; }
}
__device__ __forceinline__ void partialSM(f32x16& p0, f32x16& p1, float& m_reg, float& mn, float& alpha) {
    float pmax = p0[0];
#pragma unroll
    for (int r = 1; r < 16; ++r) pmax = fmaxf(pmax, p0[r]);
#pragma unroll
    for (int r = 0; r < 16; ++r) pmax = fmaxf(pmax, p1[r]);
    { auto rr = __builtin_amdgcn_permlane32_swap(__float_as_uint(pmax), __float_as_uint(pmax), false, false); pmax = fmaxf(__uint_as_float(rr[0]), __uint_as_float(rr[1])); }
    if (__builtin_expect(__all((pmax - m_reg) <= THR2), 1)) { mn = m_reg; alpha = 1.f; }
    else { mn = fmaxf(m_reg, pmax); alpha = __builtin_amdgcn_exp2f(m_reg - mn); m_reg = mn; }
#pragma unroll
    for (int r = 0; r < 16; ++r) p0[r] = p0[r] - mn;
#pragma unroll
    for (int r = 0; r < 16; ++r) p1[r] = p1[r] - mn;
#pragma unroll
    for (int r = 0; r < 16; ++r) p0[r] = __builtin_amdgcn_exp2f(p0[r]);
}
__device__ __forceinline__ void finishSM(f32x16& p0, f32x16& p1, float alpha, float& l_reg, bf16x8& pa0, bf16x8& pa1, bf16x8& pa2, bf16x8& pa3) {
#pragma unroll
    for (int r = 0; r < 16; ++r) p1[r] = __builtin_amdgcn_exp2f(p1[r]);
    float ps = 0;
#pragma unroll
    for (int r = 0; r < 16; ++r) ps += p0[r];
#pragma unroll
    for (int r = 0; r < 16; ++r) ps += p1[r];
    { auto rr = __builtin_amdgcn_permlane32_swap(__float_as_uint(ps), __float_as_uint(ps), false, false); ps = __uint_as_float(rr[0]) + __uint_as_float(rr[1]); }
    l_reg = l_reg * alpha + ps;
#define PK4(P, B_, OUT) do { unsigned a0 = cvtpk(P[B_+0], P[B_+1]), a1 = cvtpk(P[B_+2], P[B_+3]); unsigned b0 = cvtpk(P[B_+4], P[B_+5]), b1 = cvtpk(P[B_+6], P[B_+7]); \
        auto r0 = __builtin_amdgcn_permlane32_swap(a0, b0, false, false); auto r1 = __builtin_amdgcn_permlane32_swap(a1, b1, false, false); \
        u32x4 w = {r0[0], r1[0], r0[1], r1[1]}; OUT = *reinterpret_cast<bf16x8*>(&w); } while (0)
    PK4(p0, 0, pa0); PK4(p0, 8, pa1); PK4(p1, 0, pa2); PK4(p1, 8, pa3);
#undef PK4
}
template <int KB, int MODE>
__device__ __forceinline__ void qkt(f32x16& p0, f32x16& p1, lptr K_lds, lptr X_lds, lptr qrw, const LAS float* nckt, int r32, int hi, const bf16x8* qr) {
    if (MODE == 1) {
#pragma unroll
        for (int g = 0; g < 4; ++g) { const f32x4 a = *(const LAS f32x4*)(nckt + 8 * g + 4 * hi), b = *(const LAS f32x4*)(nckt + 32 + 8 * g + 4 * hi);
#pragma unroll
            for (int e = 0; e < 4; ++e) { p0[4 * g + e] = a[e]; p1[4 * g + e] = b[e]; } }
    } else { p0 = f32x16{}; p1 = f32x16{}; }
    lptr kb[4];
#pragma unroll
    for (int dd = 0; dd < 4; ++dd) kb[dd] = K_lds + KB * SHM_K + KSWZ(r32, (dd * 16 + hi * 8) * 2);
#pragma unroll
    for (int d0 = 0; d0 < 8; ++d0) { lptr a = kb[d0 & 3] + (d0 >> 2) * 128;
        bf16x8 b0 = *(const LAS bf16x8*)(a);
        bf16x8 b1 = *(const LAS bf16x8*)(a + 32 * 256);
        p0 = __builtin_amdgcn_mfma_f32_32x32x16_bf16(b0, qr[d0], p0, 0, 0, 0);
        p1 = __builtin_amdgcn_mfma_f32_32x32x16_bf16(b1, qr[d0], p1, 0, 0, 0); }
    if (MODE == 0) {
#pragma unroll
        for (int d0 = 0; d0 < 4; ++d0) { lptr a = X_lds + KB * SHM_KR + d0 * 2048 + r32 * 32 + hi * 16;
            bf16x8 b0 = *(const LAS bf16x8*)(a);
            bf16x8 b1 = *(const LAS bf16x8*)(a + 1024);
            bf16x8 q = *(const LAS bf16x8*)(qrw + d0 * 1024);
            p0 = __builtin_amdgcn_mfma_f32_32x32x16_bf16(b0, q, p0, 0, 0, 0);
            p1 = __builtin_amdgcn_mfma_f32_32x32x16_bf16(b1, q, p1, 0, 0, 0); }
    }
}
template <int VB>
__device__ __forceinline__ void pv_tile(f32x16* o, int vb0, bf16x8 pa0, bf16x8 pa1, bf16x8 pa2, bf16x8 pa3) {
#define TRRD(dst, off) asm volatile("ds_read_b64_tr_b16 %0, %1 offset:%2" : "=&v"(dst) : "v"(vb0), "i"(off) : "memory")
#define PV_D0(d0) do { s16x4 l0, l1, l2, l3, h0, h1, h2, h3; constexpr int b_ = VB * SHM_V + v_rd_off(d0, 0, 0); \
        TRRD(l0, b_); TRRD(h0, b_ + 2048); TRRD(l1, b_ + 4096); TRRD(h1, b_ + 6144); TRRD(l2, b_ + 8192); TRRD(h2, b_ + 10240); TRRD(l3, b_ + 12288); TRRD(h3, b_ + 14336); \
        asm volatile("s_waitcnt lgkmcnt(0)" ::: "memory"); SBAR(); \
        o[d0] = __builtin_amdgcn_mfma_f32_32x32x16_bf16(pa0, (bf16x8){l0[0], l0[1], l0[2], l0[3], h0[0], h0[1], h0[2], h0[3]}, o[d0], 0, 0, 0); \
        o[d0] = __builtin_amdgcn_mfma_f32_32x32x16_bf16(pa1, (bf16x8){l1[0], l1[1], l1[2], l1[3], h1[0], h1[1], h1[2], h1[3]}, o[d0], 0, 0, 0); \
        o[d0] = __builtin_amdgcn_mfma_f32_32x32x16_bf16(pa2, (bf16x8){l2[0], l2[1], l2[2], l2[3], h2[0], h2[1], h2[2], h2[3]}, o[d0], 0, 0, 0); \
        o[d0] = __builtin_amdgcn_mfma_f32_32x32x16_bf16(pa3, (bf16x8){l3[0], l3[1], l3[2], l3[3], h3[0], h3[1], h3[2], h3[3]}, o[d0], 0, 0, 0); } while (0)
    PV_D0(0); PV_D0(1); PV_D0(2); PV_D0(3);
#undef PV_D0
#undef TRRD
}

struct Ref { const bf16_t* Q; const bf16_t* K; const bf16_t* V; bf16_t* O; const bf16_t* Qr; const bf16_t* Kr; const float* nck; const bf16_t* G; int P0; };
struct Seam { bf16x8 qr[8]; bf16x8 st_v0, st_v1, st_k0, st_k1; int par; };

#define ROWP(p, k0, rr) ((p) + (size_t)((k0) + (rr)) * PITCH + sc)
#define VMW() asm volatile("s_waitcnt vmcnt(0)" ::: "memory")
#define VMWN(n) asm volatile("s_waitcnt vmcnt(%0)" :: "i"(n) : "memory")
#define LD8(p) (*(const bf16x8*)(p))
#define SLOAD_H(R_, k0, bf) do { S.st_v0 = LD8(ROWP((R_).V, k0, sr)); S.st_v1 = LD8(ROWP((R_).V, k0, 32 + sr)); S.st_k0 = LD8(ROWP((R_).K, k0, sr)); S.st_k1 = LD8(ROWP((R_).K, k0, 32 + sr)); \
        if (MODE == 0) glds16((R_).Kr + (size_t)(k0) * 64 + krg, (unsigned)__builtin_amdgcn_readfirstlane(xbase + (bf) * SHM_KR + wid * 1024)); } while (0)
#define SWRITE_HK(bf) do { *(LAS bf16x8*)(K_lds + (bf) * SHM_K + kws) = S.st_k0; *(LAS bf16x8*)(K_lds + (bf) * SHM_K + kws + 32 * 256) = S.st_k1; } while (0)
#define SWRITE_HV(bf) do { *(LAS bf16x8*)(V_lds + (bf) * SHM_V + vst0) = S.st_v0; *(LAS bf16x8*)(V_lds + (bf) * SHM_V + vst1) = S.st_v1; } while (0)
#define SWRITE_H(bf) do { SWRITE_HV(bf); SWRITE_HK(bf); } while (0)

template <int MODE>
__device__ __forceinline__ void side_load(const Ref& R, lptr lds, int tid, int par) {
    const int wid = __builtin_amdgcn_readfirstlane(tid >> 6), lane = tid & 63, r32 = lane & 31, hi = lane >> 5;
    if (MODE == 0) { const unsigned dst = (unsigned)(uintptr_t)(lds + OFF_QR + wid * 4096);
#pragma unroll
        for (int d0 = 0; d0 < 4; ++d0) glds16(R.Qr + (size_t)(wid * QBLK + r32) * 1024 + d0 * 16 + hi * 8, (unsigned)__builtin_amdgcn_readfirstlane(dst + d0 * 1024));
    } else { const int n4 = (R.P0 + QB) >> 2; f32x4 t0 = {0.f, 0.f, 0.f, 0.f}, t1 = t0;
        if (tid < n4) t0 = *(const f32x4*)(R.nck + 4 * tid);
        if (tid + 512 < n4) t1 = *(const f32x4*)(R.nck + 4 * (tid + 512));
        LAS f32x4* dst = (LAS f32x4*)(lds + OFF_X + par * SHM_NCK);
        dst[tid] = t0; dst[tid + 512] = t1; }
}
template <int MODE>
__device__ __forceinline__ void attn_prime(const Ref& cur, lptr lds, Seam& S) {
    int tid = threadIdx.x; asm volatile("" : "+v"(tid));
    const int wid = __builtin_amdgcn_readfirstlane(tid >> 6), lane = tid & 63, r32 = lane & 31, hi = lane >> 5;
    const int sr = tid >> 4, sc = (tid & 15) * 8, kws = KSWZ(sr, sc * 2);
    const int krg = (32 * (wid & 1) + (lane >> 1)) * 64 + (wid >> 1) * 16 + (lane & 1) * 8; const unsigned xbase = (unsigned)(uintptr_t)(lds + OFF_X);
    lptr K_lds = lds + OFF_K;
    S.par = 0;
#pragma unroll
    for (int d0 = 0; d0 < 8; ++d0) S.qr[d0] = LD8(cur.Q + (size_t)(wid * QBLK + r32) * PITCH + d0 * 16 + hi * 8);
    SLOAD_H(cur, 0, 0);
    side_load<MODE>(cur, lds, tid, 0);
    VMW(); SWRITE_HK(0);
    __syncthreads();
}
template <int MODE>
__device__ __forceinline__ void attn_block(const Ref& cur, const Ref& nxt, lptr lds, Seam& S) {
    int tid = threadIdx.x; asm volatile("" : "+v"(tid));
    const int wid = __builtin_amdgcn_readfirstlane(tid >> 6), lane = tid & 63, r32 = lane & 31, hi = lane >> 5;
    const int NT = (cur.P0 + QB - 1) / KVBLK + 1;
    const int qlo = cur.P0 + wid * QBLK;
    const int qle = MODE == 0 ? (qlo | 63) : qlo;
    const int qm = (MODE == 0 ? (qlo | 63) : qlo + r32) - 4 * hi;
    lptr V_lds = lds, K_lds = lds + OFF_K, X_lds = lds + OFF_X, qrw = lds + OFF_QR + wid * 4096 + lane * 16;
    LAS float* ws = (LAS float*)(lds + OFF_WS) + wid * 64; LAS float* li_l = ws; LAS float* al_l = ws + 32;
    const LAS float* nckb = (const LAS float*)(lds + OFF_X + S.par * SHM_NCK);
    float m_reg = -1e30f, l_reg = 0; f32x16 o[4] = {};
    const int sr = tid >> 4, sc = (tid & 15) * 8, vst0 = v_st(sr, sc), vst1 = v_st(32 + sr, sc), kws = KSWZ(sr, sc * 2);
    const int krg = (32 * (wid & 1) + (lane >> 1)) * 64 + (wid >> 1) * 16 + (lane & 1) * 8; const unsigned xbase = (unsigned)(uintptr_t)(lds + OFF_X);
    const int vb0 = (int)(uintptr_t)V_lds + v_rd_base(lane);
#define RESC(a) do { if (__any((a) < 1.f)) { if (hi == 0) al_l[r32] = (a); asm volatile("s_waitcnt lgkmcnt(0)" ::: "memory"); \
                     for (int d_ = 0; d_ < 4; ++d_) for (int r = 0; r < 16; ++r) o[d_][r] *= al_l[crow(r, hi)]; } } while (0)
#define KBASE(t) ((t) * KVBLK)
#define MASKT(P0_, P1_, t) do { const int kb_ = KBASE(t); if (kb_ + KVBLK - 1 > qle) mask_tile(P0_, P1_, qm - kb_); } while (0)
#define QKT(KB, PX0, PX1, t) qkt<KB, MODE>(PX0, PX1, K_lds, X_lds, qrw, nckb + KBASE(t), r32, hi, S.qr)
    f32x16 pA0, pA1, pB0, pB1; float mnA, mnB, alA, alB; bf16x8 pa0, pa1, pa2, pa3;
    SWRITE_HV(0); SBAR();
    SLOAD_H(cur, KBASE(1), 1);
    SBAR(); QKT(0, pA0, pA1, 0);
    MASKT(pA0, pA1, 0); partialSM(pA0, pA1, m_reg, mnA, alA);
    VMW(); SWRITE_H(1);
    __syncthreads();
#define HALF_STEP(PX0, PX1, mnX, alX, PY0, PY1, alY, t, KB, VB, SB) do { \
        SBAR(); QKT(KB, PX0, PX1, t); \
        finishSM(PY0, PY1, alY, l_reg, pa0, pa1, pa2, pa3); SBAR(); \
        if ((t) + 1 < NT) { SLOAD_H(cur, KBASE((t) + 1), SB); SBAR(); } \
        pv_tile<VB>(o, vb0, pa0, pa1, pa2, pa3); MASKT(PX0, PX1, (t)); partialSM(PX0, PX1, m_reg, mnX, alX); \
        __syncthreads(); \
        if ((t) + 1 < NT) { VMW(); SWRITE_H(SB); } \
        RESC(alX); __syncthreads(); } while (0)
    for (int t = 1; t + 1 < NT; t += 2) {
        HALF_STEP(pB0, pB1, mnB, alB, pA0, pA1, alA, t, 1, 0, 0);
        HALF_STEP(pA0, pA1, mnA, alA, pB0, pB1, alB, t + 1, 0, 1, 1);
    }
    const bool even = (NT & 1) == 0;
    if (even) { SBAR(); QKT(1, pB0, pB1, NT - 1); SBAR(); }
    SLOAD_H(nxt, 0, 0); SBAR();
    if (MODE == 0) { side_load<MODE>(nxt, lds, tid, 0); SBAR(); }
#pragma unroll
    for (int d0 = 0; d0 < 8; ++d0) S.qr[d0] = LD8(nxt.Q + (size_t)(wid * QBLK + r32) * PITCH + d0 * 16 + hi * 8);
    SBAR();
    finishSM(pA0, pA1, alA, l_reg, pa0, pa1, pa2, pa3); SBAR();
    pv_tile<0>(o, vb0, pa0, pa1, pa2, pa3);
    if (even) { MASKT(pB0, pB1, NT - 1); partialSM(pB0, pB1, m_reg, mnB, alB); __syncthreads(); RESC(alB);
        finishSM(pB0, pB1, alB, l_reg, pa0, pa1, pa2, pa3); SBAR(); pv_tile<1>(o, vb0, pa0, pa1, pa2, pa3); }
    SBAR(); VMWN(8); SWRITE_HK(0); SBAR();
    if (hi == 0) li_l[r32] = l_reg; asm volatile("s_waitcnt lgkmcnt(0)" ::: "memory");
    float rli[16];
#pragma unroll
    for (int r = 0; r < 16; ++r) rli[r] = __builtin_amdgcn_rcpf(li_l[crow(r, hi)]);
    bf16_t* Ow = cur.O + (size_t)(wid * QBLK) * PITCH; const bf16_t* Gw = cur.G + (size_t)(wid * QBLK) * PITCH;
#pragma unroll
    for (int r = 0; r < 16; ++r) { const int orow = crow(r, hi);
#pragma unroll
        for (int d0 = 0; d0 < 4; ++d0) { float v = o[d0][r] * rli[r];
            if (MODE == 1) v *= bf2f(Gw[(size_t)orow * PITCH + d0 * 32 + r32]);
            const float vn = __uint_as_float(__builtin_amdgcn_mov_dpp(__float_as_uint(v), 0xB1, 0xf, 0xf, true));
            if ((r32 & 1) == 0) *(unsigned*)(Ow + (size_t)orow * PITCH + d0 * 32 + r32) = cvtpk(v, vn); } }
    if (MODE == 1) side_load<MODE>(nxt, lds, tid, S.par ^ 1);
    S.par ^= 1;
    __syncthreads();
#undef RESC
#undef KBASE
#undef MASKT
#undef QKT
#undef HALF_STEP
}
#undef ROWP
#undef VMW
#undef VMWN
#undef LD8
#undef SLOAD_H
#undef SWRITE_HK
#undef SWRITE_HV
#undef SWRITE_H

struct Bufs { const bf16_t* Q; const bf16_t* K; const bf16_t* V; bf16_t* O; const bf16_t* Qr; const bf16_t* Kr; const float* nck; const bf16_t* G; };
__device__ __forceinline__ Ref make_ref(const Bufs& B, int item, int pass) {
    const int bh = item >> 3, x = item & 7, qb = pass ? 15 - x : x, b = bh >> 4, hh = bh & 15;
    const size_t t0 = (size_t)b * S, tq = t0 + (size_t)qb * QB;
    Ref r; r.Q = B.Q + tq * PITCH + hh * 128; r.O = B.O + tq * PITCH + hh * 128; r.G = B.G + tq * PITCH + hh * 128;
    r.K = B.K + t0 * PITCH + hh * 128; r.V = B.V + t0 * PITCH + hh * 128; r.Qr = B.Qr + tq * 1024 + hh * 64; r.Kr = B.Kr + t0 * 64; r.nck = B.nck + (size_t)bh * S; r.P0 = qb * QB;
    return r;
}
template <int MODE>
__device__ __forceinline__ void attn_phase(lptr lds, const Bufs& B, int vcu, int G) {
    constexpr int total = NB * NH * 8;
    int L = vcu; if (L >= total) return;
    int pass = 0; Ref cur = make_ref(B, L, 0);
    Seam S;
    attn_prime<MODE>(cur, lds, S);
    for (;;) {
        const bool more_pass = pass == 0, more_item = L + G < total, last = !more_pass && !more_item;
        int passn = pass + 1, Ln = L;
        if (!more_pass) { passn = 0; Ln = more_item ? L + G : L; }
        const Ref nxt = last ? cur : make_ref(B, Ln, passn);
        attn_block<MODE>(cur, nxt, lds, S);
        if (last) break;
        cur = nxt; pass = passn; L = Ln;
    }
}
}

struct Args { const float* in[26]; float* out; unsigned char* ws; int L0, L1, ph_lo, ph_hi, use_bar, pad; };
enum { PH_PRO = 0, PH_NORM = 1, PH_MLA_A = 2, PH_MLA_PREP = 3, PH_MLA_QKV = 4, PH_MLA_ATT = 5, PH_MLA_WO = 6, PH_FOX_A = 7, PH_FOX_PREP = 8, PH_FOX_ATT = 9, PH_FOX_WO = 10,
       PH_ROUTER = 11, PH_MOE_GU = 12, PH_MOE_D = 13, PH_FINAL = 14, PH_END = 15 };

struct CvtJob { const float* src; int ld, K, ncols, perm, k0; bf16_t* dst; int drow0; };
__device__ __forceinline__ bool cvt_decode(const Args& A, int r, CvtJob& J) {
    unsigned char* ws = A.ws; J.ncols = 64; J.perm = 0; J.K = 2048;
    if (r < 512) { const int j = r >> 8, q = r & 255, kb = q >> 3, nb = q & 7; J.src = A.in[5] + (size_t)j * 2048 * 512 + nb * 64; J.ld = 512; J.dst = (bf16_t*)(ws + WS_W_MLA_A) + (size_t)j * 1280 * 2048; J.drow0 = nb * 64; J.k0 = kb * 64; return true; } r -= 512;
    if (r < 576) { const int j = r / 288, q = r % 288, kb = q / 9, nb = q % 9; J.src = A.in[8] + (size_t)j * 2048 * 576 + nb * 64; J.ld = 576; J.dst = (bf16_t*)(ws + WS_W_MLA_A) + (size_t)j * 1280 * 2048; J.drow0 = 512 + nb * 64; J.k0 = kb * 64; return true; } r -= 576;
    if (r < 768) { const int j = r / 384, q = r % 384, kb = q / 48, nb = q % 48, hh = nb / 3, part = nb % 3; J.src = A.in[7] + (size_t)j * 512 * 3072 + hh * 192 + part * 64; J.ld = 3072; J.K = 512;
        J.dst = (bf16_t*)(ws + WS_W_MLA_UQ) + (size_t)j * 3072 * 512; J.drow0 = part < 2 ? hh * 128 + part * 64 : 2048 + hh * 64; J.perm = part == 2; J.k0 = kb * 64; return true; } r -= 768;
    if (r < 1024) { const int j = r >> 9, q = r & 511, kb = q >> 6, nb = q & 63, hh = nb >> 2, which = (nb >> 1) & 1, half = nb & 1; J.src = A.in[10] + (size_t)j * 512 * 4096 + nb * 64; J.ld = 4096; J.K = 512;
        J.dst = (bf16_t*)(ws + WS_W_MLA_UKV) + (size_t)j * 4096 * 512; J.drow0 = which * 2048 + hh * 128 + half * 64; J.k0 = kb * 64; return true; } r -= 1024;
    if (r < 2048) { const int j = r >> 10, q = r & 1023, kb = q >> 5, nb = q & 31; J.src = A.in[11] + (size_t)j * 2048 * 2048 + nb * 64; J.ld = 2048; J.dst = (bf16_t*)(ws + WS_W_MLA_O) + (size_t)j * 2048 * 2048; J.drow0 = nb * 64; J.k0 = kb * 64; return true; } r -= 2048;
    if (r < 6144) { const int j = r / 3072, q = r % 3072, kb = q / 96, nb = q % 96; J.src = A.in[12] + (size_t)j * 2048 * 6144 + nb * 64; J.ld = 6144; J.dst = (bf16_t*)(ws + WS_W_FOX_A) + (size_t)j * 8448 * 2048; J.drow0 = nb * 64; J.k0 = kb * 64; return true; } r -= 6144;
    if (r < 2048) { const int j = r >> 10, q = r & 1023, kb = q >> 5, nb = q & 31; J.src = A.in[17] + (size_t)j * 2048 * 2048 + nb * 64; J.ld = 2048; J.dst = (bf16_t*)(ws + WS_W_FOX_A) + (size_t)j * 8448 * 2048; J.drow0 = 6144 + nb * 64; J.k0 = kb * 64; return true; } r -= 2048;
    if (r < 64) { const int j = r >> 5, kb = r & 31; J.src = A.in[15] + (size_t)j * 2048 * 16; J.ld = 16; J.ncols = 16; J.dst = (bf16_t*)(ws + WS_W_FOX_A) + (size_t)j * 8448 * 2048; J.drow0 = 8192; J.k0 = kb * 64; return true; } r -= 64;
    if (r < 2048) { const int j = r >> 10, q = r & 1023, kb = q >> 5, nb = q & 31; J.src = A.in[18] + (size_t)j * 2048 * 2048 + nb * 64; J.ld = 2048; J.dst = (bf16_t*)(ws + WS_W_FOX_O) + (size_t)j * 2048 * 2048; J.drow0 = nb * 64; J.k0 = kb * 64; return true; } r -= 2048;
    if (r < 65536) { const int up = r >> 15, rr = r & 32767, le = rr >> 8, q = rr & 255, kb = q >> 3, nb = q & 7; J.src = A.in[23 + up] + (size_t)le * 2048 * 512 + nb * 64; J.ld = 512;
        J.dst = (bf16_t*)(ws + WS_W_GU) + (size_t)le * 1024 * 2048; J.drow0 = 256 * (nb >> 1) + 128 * up + 64 * (nb & 1); J.k0 = kb * 64; return true; } r -= 65536;
    if (r < 32768) { const int le = r >> 8, q = r & 255, kb = q >> 5, nb = q & 31; J.src = A.in[25] + (size_t)le * 512 * 2048 + nb * 64; J.ld = 2048; J.K = 512; J.dst = (bf16_t*)(ws + WS_W_D) + (size_t)le * 2048 * 512; J.drow0 = nb * 64; J.k0 = kb * 64; return true; }
    return false;
}
constexpr int CVT_ITEMS = 512 + 576 + 768 + 1024 + 2048 + 6144 + 2048 + 64 + 2048 + 65536 + 32768;
__device__ __forceinline__ void cvt_item(const CvtJob& J, LAS float* scr, int lane) {
    const int kr = lane >> 4, c4 = (lane & 15) * 4;
    if (c4 < J.ncols) {
#pragma unroll 4
        for (int it = 0; it < 16; ++it) { const int k = it * 4 + kr; const f32x4 v = *(const f32x4*)(J.src + (size_t)(J.k0 + k) * J.ld + c4);
            LAS float* p = scr + k * 65 + c4; p[0] = v[0]; p[1] = v[1]; p[2] = v[2]; p[3] = v[3]; }
    }
    LDS_WAIT(); asm volatile("" ::: "memory");
    const int ck = lane & 7;
#pragma unroll
    for (int it = 0; it < 8; ++it) { const int n = (lane >> 3) + 8 * it;
        if (n < J.ncols) { const int sn = J.perm ? ((n >> 1) + 32 * (n & 1)) : n; const LAS float* s = scr + (8 * ck) * 65 + sn;
            u32x4 o; o.x = pk2(s[0], s[65]); o.y = pk2(s[2 * 65], s[3 * 65]); o.z = pk2(s[4 * 65], s[5 * 65]); o.w = pk2(s[6 * 65], s[7 * 65]);
            *(u32x4*)(J.dst + (size_t)(J.drow0 + n) * J.K + J.k0 + 8 * ck) = o; } }
    LDS_WAIT(); asm volatile("" ::: "memory");
}

__global__ void __launch_bounds__(512, 2) mega(Args args) {
    extern __shared__ __attribute__((aligned(16))) unsigned char lds_raw[];
    LAS unsigned char* lds = (LAS unsigned char*)lds_raw;
    const int tid = threadIdx.x, lane = tid & 63, wave = __builtin_amdgcn_readfirstlane(tid >> 6);
    const int G = gridDim.x; const int bx = blockIdx.x; const int vcu = (G % 8 == 0) ? (bx % 8) * (G / 8) + bx / 8 : bx;
    unsigned char* ws = args.ws;
    unsigned* ctl = (unsigned*)(ws + WS_CTL);
    for (int u = tid; u < LDS_CTL_BYTES / 4; u += 512) ((LAS unsigned*)lds)[u] = 0u;
    __syncthreads();
    XcdBarrier bar; bar.bar = ctl + CW_BAR; bar.x = 0; bar.st = (volatile LAS unsigned*)lds;
    if (args.use_bar) bar = xcd_barrier_post(ctl + CW_BAR, (volatile LAS unsigned*)lds);
#define GRID_BAR() do { if (args.use_bar) xcd_barrier(bar); } while (0)
    const int lo = args.ph_lo, hi = args.ph_hi;
#define IN(k) (lo <= (k) && (k) < hi)
    float* h = args.out;
    bf16_t* abf = (bf16_t*)(ws + WS_ABF); bf16_t* y2 = (bf16_t*)(ws + WS_Y2);
    const float* cs = (const float*)(ws + WS_ROPE);
    const int gw = vcu * 8 + wave, NGW = G * 8;

    if (IN(PH_PRO) && args.L0 == 0) {
        LAS float* scr = (LAS float*)(lds + RING_OFF) + wave * (64 * 65);
        for (int it = gw; it < CVT_ITEMS; it += NGW) { CvtJob J; if (cvt_decode(args, it, J)) cvt_item(J, scr, lane); }
        for (int it = gw; it < 2 * 192 + 2 * 240; it += NGW) { bf16_t* rowp;
            if (it < 384) { const int j = it / 192, rr = it % 192; rowp = (bf16_t*)(ws + WS_W_MLA_A) + ((size_t)j * 1280 + 1088 + rr) * 2048; }
            else { const int q = it - 384, j = q / 240, rr = q % 240; rowp = (bf16_t*)(ws + WS_W_FOX_A) + ((size_t)j * 8448 + 8208 + rr) * 2048; }
#pragma unroll
            for (int c = 0; c < 4; ++c) ((u32x4*)rowp)[lane + 64 * c] = (u32x4){0u, 0u, 0u, 0u}; }
        { const int* pos = (const int*)args.in[1]; float2* cst = (float2*)(ws + WS_ROPE);
          for (int i = (vcu * 512 + tid); i < T * 32; i += G * 512) { const int t = i >> 5, f = i & 31; const float inv = powf(10000.0f, -(float)(2 * f) / 64.0f); const float ang = (float)pos[t] * inv;
              cst[i] = make_float2((float)cos((double)ang), (float)sin((double)ang)); } }
        GRID_BAR();
    }

    for (int L = args.L0; L < args.L1; ++L) {
        const int j = L >> 1; const bool mla = (L & 1) == 0;
        if (IN(PH_MLA_A) && mla) {
            pg8::Gemm g{abf, (const bf16_t*)(ws + WS_W_MLA_A) + (size_t)j * 1280 * 2048, 2048, 0}; pg8::StaticOrder S; S.init(T, 1280, G, bx);
            pg8::EpiBf16S E{(bf16_t*)(ws + WS_RAW), 1280, 0, 0, 1.0f};
            pg8::gemm_phase<pg8::EpiBf16S, pg8::StaticOrder, false>(lds + RING_OFF, g, S, E);
            GRID_BAR();
        }
        if (IN(PH_MLA_QKV) && mla) {
            { pg8::Gemm g{(const bf16_t*)(ws + WS_CQ), (const bf16_t*)(ws + WS_W_MLA_UQ) + (size_t)j * 3072 * 512, 512, 0}; pg8::StaticOrder S; S.init(T, 3072, G, bx);
              pg8::EpiMlaQ E{(bf16_t*)(ws + WS_QN), (bf16_t*)(ws + WS_QR), cs};
              pg8::gemm_phase<pg8::EpiMlaQ, pg8::StaticOrder, false>(lds + RING_OFF, g, S, E); }
            { pg8::Gemm g{(const bf16_t*)(ws + WS_CKV), (const bf16_t*)(ws + WS_W_MLA_UKV) + (size_t)j * 4096 * 512, 512, 0}; pg8::StaticOrder S; S.init(T, 4096, G, bx);
              pg8::EpiBf16S E{(bf16_t*)(ws + WS_KN), 2048, 2048, (WS_V - WS_KN) / 2, 1.0f};
              pg8::gemm_phase<pg8::EpiBf16S, pg8::StaticOrder, false>(lds + RING_OFF, g, S, E); }
            GRID_BAR();
        }
        if (IN(PH_MLA_ATT) && mla) {
            const att::Bufs B{(const bf16_t*)(ws + WS_QN), (const bf16_t*)(ws + WS_KN), (const bf16_t*)(ws + WS_V), (bf16_t*)(ws + WS_QN), (const bf16_t*)(ws + WS_QR), (const bf16_t*)(ws + WS_KR),
                              (const float*)(ws + WS_NCK), (const bf16_t*)(ws + WS_QN)};
            att::attn_phase<0>((att::lptr)(lds + RING_OFF), B, vcu, G);
            GRID_BAR();
        }
        if (IN(PH_MLA_WO) && mla) {
            pg8::Gemm g{(const bf16_t*)(ws + WS_QN), (const bf16_t*)(ws + WS_W_MLA_O) + (size_t)j * 2048 * 2048, 2048, 0}; pg8::StaticOrder S; S.init(T, 2048, G, bx);
            pg8::EpiRes E{h};
            pg8::gemm_phase<pg8::EpiRes, pg8::StaticOrder, false>(lds + RING_OFF, g, S, E);
            GRID_BAR();
        }
        if (IN(PH_FOX_A) && !mla) {
            pg8::Gemm g{abf, (const bf16_t*)(ws + WS_W_FOX_A) + (size_t)j * 8448 * 2048, 2048, 0}; pg8::StaticOrder S; S.init(T, 8448, G, bx);
            pg8::EpiFoxA E{(bf16_t*)(ws + WS_FQ), (WS_FK - WS_FQ) / 2, (float*)(ws + WS_LOGF), args.in[16] + j * 16};
            pg8::gemm_phase<pg8::EpiFoxA, pg8::StaticOrder, false>(lds + RING_OFF, g, S, E);
            GRID_BAR();
        }
        if (IN(PH_FOX_ATT) && !mla) {
            const att::Bufs B{(const bf16_t*)(ws + WS_FQ), (const bf16_t*)(ws + WS_FK), (const bf16_t*)(ws + WS_FV), (bf16_t*)(ws + WS_FQ), (const bf16_t*)(ws + WS_FQ), (const bf16_t*)(ws + WS_FK),
                              (const float*)(ws + WS_NCK), (const bf16_t*)(ws + WS_FG)};
            att::attn_phase<1>((att::lptr)(lds + RING_OFF), B, vcu, G);
            GRID_BAR();
        }
        if (IN(PH_FOX_WO) && !mla) {
            pg8::Gemm g{(const bf16_t*)(ws + WS_FQ), (const bf16_t*)(ws + WS_W_FOX_O) + (size_t)j * 2048 * 2048, 2048, 0}; pg8::StaticOrder S; S.init(T, 2048, G, bx);
            pg8::EpiRes E{h};
            pg8::gemm_phase<pg8::EpiRes, pg8::StaticOrder, false>(lds + RING_OFF, g, S, E);
            GRID_BAR();
        }
        if (IN(PH_MOE_GU) || IN(PH_MOE_D)) {
            const unsigned* cnt = ctl + CW_CNT + L * 64; LAS int* pre = (LAS int*)(lds + 64);
            if (tid == 0) { int p = 0; for (int e = 0; e < NE; ++e) { pre[e] = p; p += ((int)cnt[e] + 255) >> 8; } pre[NE] = p; }
            __syncthreads();
            const int* rowlist = (const int*)(ws + WS_ROWLIST); const float* roww = (const float*)(ws + WS_ROWW);
            if (IN(PH_MOE_GU)) {
                pg8::Gemm g{abf, (const bf16_t*)(ws + WS_W_GU) + (size_t)L * NE * 1024 * 2048, 2048, (size_t)1024 * 2048}; pg8::MoeOrder S; S.init(pre, rowlist, cnt, 4, G, bx);
                pg8::EpiGU E{(bf16_t*)(ws + WS_HID)};
                pg8::gemm_phase<pg8::EpiGU, pg8::MoeOrder, true>(lds + RING_OFF, g, S, E);
                GRID_BAR();
            }
            if (IN(PH_MOE_D)) {
                pg8::Gemm g{(const bf16_t*)(ws + WS_HID), (const bf16_t*)(ws + WS_W_D) + (size_t)L * NE * 2048 * 512, 512, (size_t)2048 * 512}; pg8::MoeOrder S; S.init(pre, rowlist, cnt, 8, G, bx);
                pg8::EpiDown E{y2, rowlist, roww, cnt};
                pg8::gemm_phase<pg8::EpiDown, pg8::MoeOrder, false>(lds + RING_OFF, g, S, E);
                GRID_BAR();
            }
        }
    }
#undef IN
#undef GRID_BAR
}

#ifndef FAST_GEMM
#define FAST_GEMM 1
#endif
#ifndef FAST_ATT_MLA
#define FAST_ATT_MLA 1
#endif
#ifndef FAST_ATT_FOX
#define FAST_ATT_FOX 1
#endif
#ifndef FAST_MOE
#define FAST_MOE 1
#endif
static void launch_mega(const Args& base, int L, int ph, int grid, hipStream_t stream) {
    Args a = base; a.L0 = L; a.L1 = L + 1; a.ph_lo = ph; a.ph_hi = ph + 1; a.use_bar = 0; a.pad = 0;
    hipLaunchKernelGGL(mega, dim3(grid), dim3(512), LDS_BYTES, stream, a);
}
extern "C" void kernel_launch(void* const* d_in, const int* in_sizes, int n_in, void* d_out, int out_size, void* d_ws, size_t ws_size, hipStream_t stream) {
    if (n_in != 26 || out_size != T * D || ws_size < WS_END) { fprintf(stderr, "kernel_launch: unexpected shapes (n_in %d, out %d, ws %zu)\n", n_in, out_size, ws_size); return; }
    static int grid = 0;
    if (grid == 0) {
        int dev = 0, cus = 0;
        if (hipGetDevice(&dev) != hipSuccess || hipDeviceGetAttribute(&cus, hipDeviceAttributeMultiprocessorCount, dev) != hipSuccess || cus <= 0) cus = 256;
        if (hipFuncSetAttribute((const void*)mega, hipFuncAttributeMaxDynamicSharedMemorySize, LDS_BYTES) != hipSuccess) { fprintf(stderr, "kernel_launch: hipFuncSetAttribute failed\n"); grid = -1; return; }
        int per_cu = 0; (void)hipOccupancyMaxActiveBlocksPerMultiprocessor(&per_cu, (const void*)mega, 512, LDS_BYTES); (void)hipGetLastError();
        if (per_cu < 1) fprintf(stderr, "kernel_launch: occupancy query reports %d blocks per CU\n", per_cu);
        grid = cus;
    }
    if (grid < 0) return;
    unsigned char* ws = (unsigned char*)d_ws;
    const float* x = (const float*)d_in[0]; const int* pos = (const int*)d_in[1];
    const float* attn_norm = (const float*)d_in[2]; const float* ffn_norm = (const float*)d_in[3]; const float* final_norm = (const float*)d_in[4];
    float* h = (float*)d_out;
    float2* cs = (float2*)(ws + WS_ROPE); float* logf = (float*)(ws + WS_LOGF); float* nck = (float*)(ws + WS_NCK);
    int* rowlist = (int*)(ws + WS_ROWLIST); float* roww = (float*)(ws + WS_ROWW); bf16_t* kr = (bf16_t*)(ws + WS_KR);
    bf16_t* abf = (bf16_t*)(ws + WS_ABF); bf16_t* y2 = (bf16_t*)(ws + WS_Y2);
    unsigned* ctl = (unsigned*)(ws + WS_CTL);
    (void)hipMemsetAsync(ws + WS_CTL, 0, CTL_BYTES, stream);
    Args base{}; for (int i = 0; i < 26; ++i) base.in[i] = (const float*)d_in[i]; base.out = h; base.ws = ws;
#if FAST_GEMM
    launch_mega(base, 0, PH_PRO, grid, stream);
#else
    k_rope_table<<<T * 32 / 256, 256, 0, stream>>>(pos, cs);
#endif
    for (int L = 0; L < 4; ++L) {
        const int j = L >> 1;
        if (L == 0) k_norm<0><<<T / 8, 512, 0, stream>>>(x, h, nullptr, attn_norm, abf);
        else k_norm<1><<<T / 8, 512, 0, stream>>>(h, h, y2, attn_norm + (size_t)L * D, abf);
        if ((L & 1) == 0) {
            bf16_t* raw = (bf16_t*)(ws + WS_RAW); bf16_t* cq = (bf16_t*)(ws + WS_CQ); bf16_t* ckv = (bf16_t*)(ws + WS_CKV);
            bf16_t* Qn = (bf16_t*)(ws + WS_QN); bf16_t* Qr = (bf16_t*)(ws + WS_QR); bf16_t* Kn = (bf16_t*)(ws + WS_KN); bf16_t* V = (bf16_t*)(ws + WS_V);
#if FAST_GEMM
            launch_mega(base, L, PH_MLA_A, grid, stream);
#else
            k_n_mla_a<<<dim3(3, T), 256, 0, stream>>>(abf, (const float*)d_in[5] + (size_t)j * D * 512, (const float*)d_in[8] + (size_t)j * D * 576, raw);
#endif
            k_mla_prep<<<T / 8, 512, 0, stream>>>(raw, (const float*)d_in[6] + j * 512, (const float*)d_in[9] + j * 512, cs, cq, ckv, kr);
#if FAST_GEMM
            launch_mega(base, L, PH_MLA_QKV, grid, stream);
#else
            k_n_mla_uq<<<dim3(6, T), 256, 0, stream>>>(cq, (const float*)d_in[7] + (size_t)j * 512 * 3072, cs, Qn, Qr);
            k_n_mla_ukv<<<dim3(8, T), 256, 0, stream>>>(ckv, (const float*)d_in[10] + (size_t)j * 512 * 4096, Kn, V);
#endif
#if FAST_ATT_MLA
            launch_mega(base, L, PH_MLA_ATT, grid, stream);
#else
            k_nattn<0><<<T * NH / 8, 512, 0, stream>>>(Qn, Qr, Kn, kr, V, nullptr, nullptr, Qn);
#endif
#if FAST_GEMM
            launch_mega(base, L, PH_MLA_WO, grid, stream);
#else
            k_n_wo<<<dim3(4, T), 256, 0, stream>>>(Qn, (const float*)d_in[11] + (size_t)j * D * D, h);
#endif
        } else {
            bf16_t* Q = (bf16_t*)(ws + WS_FQ); bf16_t* K = (bf16_t*)(ws + WS_FK); bf16_t* V = (bf16_t*)(ws + WS_FV); bf16_t* G = (bf16_t*)(ws + WS_FG);
#if FAST_GEMM
            launch_mega(base, L, PH_FOX_A, grid, stream);
#else
            k_n_fox_a<<<dim3(17, T), 256, 0, stream>>>(abf, (const float*)d_in[12] + (size_t)j * D * 6144, (const float*)d_in[17] + (size_t)j * D * D, (const float*)d_in[15] + (size_t)j * D * 16,
                                                     (const float*)d_in[16] + j * 16, Q, K, V, G, logf);
#endif
            k_fox_qknorm<<<T / 8, 512, 0, stream>>>(Q, K, (const float*)d_in[13] + j * 128, (const float*)d_in[14] + j * 128);
            k_fox_scan<<<NB * NH, 64, 0, stream>>>(logf, nck);
#if FAST_ATT_FOX
            launch_mega(base, L, PH_FOX_ATT, grid, stream);
#else
            k_nattn<1><<<T * NH / 8, 512, 0, stream>>>(Q, nullptr, K, nullptr, V, nck, G, Q);
#endif
#if FAST_GEMM
            launch_mega(base, L, PH_FOX_WO, grid, stream);
#else
            k_n_wo<<<dim3(4, T), 256, 0, stream>>>(Q, (const float*)d_in[18] + (size_t)j * D * D, h);
#endif
        }
        unsigned* cnt = ctl + CW_CNT + L * 64;
        k_n_router<<<T / 8, 512, 0, stream>>>(h, ffn_norm + (size_t)L * D, (const float*)d_in[19] + (size_t)L * D * 8, (const float*)d_in[20] + L * 8,
                                              (const float*)d_in[21] + (size_t)L * D * 32, (const float*)d_in[22] + L * 32, abf, cnt, rowlist, roww);
        bf16_t* hid = (bf16_t*)(ws + WS_HID);
#if FAST_MOE
        launch_mega(base, L, PH_MOE_GU, grid, stream);
        launch_mega(base, L, PH_MOE_D, grid, stream);
#else
        k_n_moe_gu<<<dim3(HID_ROWS, 2), 256, 0, stream>>>(abf, (const float*)d_in[23] + (size_t)L * NE * D * FF, (const float*)d_in[24] + (size_t)L * NE * D * FF, cnt, rowlist, hid);
        k_n_moe_d<<<dim3(HID_ROWS, 4), 256, 0, stream>>>(hid, (const float*)d_in[25] + (size_t)L * NE * FF * D, cnt, rowlist, roww, y2);
#endif
    }
    k_norm<1><<<T / 8, 512, 0, stream>>>(h, h, y2, final_norm, abf);
    k_norm<2><<<T / 8, 512, 0, stream>>>(h, h, nullptr, final_norm, nullptr);
}
```

```cpp
#include <hip/hip_runtime.h>
#include <cstdio>
#include <cstdint>

typedef unsigned short bf16_t;
typedef float f32x4 __attribute__((ext_vector_type(4)));
typedef unsigned u32x4 __attribute__((ext_vector_type(4)));
typedef unsigned u32x2 __attribute__((ext_vector_type(2)));

constexpr int T = 32768, D = 2048, NB = 8, S = 4096, NH = 16, DH = 128;
constexpr int QL = 512, KVL = 512, ROPE = 64;
constexpr int NE = 32, NG = 8, EPG = 4, FF = 512;
constexpr int ECAP = 32768;
constexpr int HID_ROWS = 73728;
constexpr float EPS = 1e-6f;
constexpr float LOG2E = 1.4426950408889634f;
constexpr float QS_MLA = 0.07216878364870322f * LOG2E;
constexpr float QS_FOX = 0.08838834764831845f * LOG2E;

constexpr size_t MiB = 1ull << 20;
constexpr size_t WS_CTL = 0, CTL_BYTES = 1 * MiB;
constexpr size_t WS_ROPE = 1 * MiB;
constexpr size_t WS_LOGF = 9 * MiB;
constexpr size_t WS_NCK = 11 * MiB;
constexpr size_t WS_ROWLIST = 16 * MiB;
constexpr size_t WS_ROWW = 20 * MiB;
constexpr size_t WS_KR = 24 * MiB;
constexpr size_t WS_ABF = 928 * MiB;
constexpr size_t WS_Y2 = 1056 * MiB;
constexpr size_t WS_ARENA = 1312 * MiB;
constexpr size_t WS_RAW = WS_ARENA;
constexpr size_t WS_CQ = WS_ARENA + 80 * MiB;
constexpr size_t WS_CKV = WS_ARENA + 112 * MiB;
constexpr size_t WS_QN = WS_ARENA + 144 * MiB;
constexpr size_t WS_QR = WS_ARENA + 272 * MiB;
constexpr size_t WS_KN = WS_ARENA + 336 * MiB;
constexpr size_t WS_V = WS_ARENA + 464 * MiB;
constexpr size_t WS_FQ = WS_ARENA;
constexpr size_t WS_FK = WS_ARENA + 128 * MiB;
constexpr size_t WS_FV = WS_ARENA + 256 * MiB;
constexpr size_t WS_FG = WS_ARENA + 384 * MiB;
constexpr size_t WS_HID = WS_ARENA;
constexpr size_t WS_END = 2048 * MiB;
constexpr int CW_CNT = 1024;

struct Ptrs {
    const float* in[26]; float* out; unsigned char* ws;
};

__device__ __forceinline__ float bf2f(bf16_t v) { return __uint_as_float((unsigned)v << 16); }
__device__ __forceinline__ unsigned f2bf(float f) { unsigned u = __float_as_uint(f); return (u + 0x7fffu + ((u >> 16) & 1u)) >> 16; }
__device__ __forceinline__ unsigned pk2(float lo, float hi) { return f2bf(lo) | (f2bf(hi) << 16); }
__device__ __forceinline__ float bfr(float f) { return __uint_as_float(f2bf(f) << 16); }
__device__ __forceinline__ float wave_sum(float v) {
#pragma unroll
    for (int o = 32; o >= 1; o >>= 1) v += __shfl_xor(v, o);
    return v;
}
__device__ __forceinline__ float wave_max(float v) {
#pragma unroll
    for (int o = 32; o >= 1; o >>= 1) v = fmaxf(v, __shfl_xor(v, o));
    return v;
}

__global__ void k_rope_table(const int* pos, float2* cs) {
    const int i = blockIdx.x * blockDim.x + threadIdx.x; if (i >= T * 32) return;
    const int t = i >> 5, f = i & 31;
    const float inv = powf(10000.0f, -(float)(2 * f) / 64.0f);
    const float ang = (float)pos[t] * inv;
    cs[i] = make_float2((float)cos((double)ang), (float)sin((double)ang));
}

template <int MODE  >
__global__ void __launch_bounds__(512) k_norm(const float* src, float* h, const bf16_t* y2, const float* gain, bf16_t* abf) {
    const int row = blockIdx.x * 8 + (threadIdx.x >> 6), lane = threadIdx.x & 63;
    const f32x4* s4 = (const f32x4*)(src + (size_t)row * D) + lane;
    f32x4 v[8]; float ss = 0.f;
#pragma unroll
    for (int j = 0; j < 8; ++j) v[j] = s4[64 * j];
    if (MODE == 1) {
        const u32x2* ya = (const u32x2*)(y2 + (size_t)(2 * row) * D) + lane; const u32x2* yb = (const u32x2*)(y2 + (size_t)(2 * row + 1) * D) + lane;
#pragma unroll
        for (int j = 0; j < 8; ++j) { const u32x2 a = ya[64 * j], b = yb[64 * j];
            v[j][0] += __uint_as_float(a.x << 16) + __uint_as_float(b.x << 16); v[j][1] += __uint_as_float(a.x & 0xffff0000u) + __uint_as_float(b.x & 0xffff0000u);
            v[j][2] += __uint_as_float(a.y << 16) + __uint_as_float(b.y << 16); v[j][3] += __uint_as_float(a.y & 0xffff0000u) + __uint_as_float(b.y & 0xffff0000u); }
    }
#pragma unroll
    for (int j = 0; j < 8; ++j) ss += (v[j][0] * v[j][0] + v[j][1] * v[j][1]) + (v[j][2] * v[j][2] + v[j][3] * v[j][3]);
    const float rstd = 1.0f / sqrtf(wave_sum(ss) * (1.0f / D) + EPS);
    const f32x4* g4 = (const f32x4*)gain + lane;
    if (MODE == 2) {
        f32x4* o4 = (f32x4*)(h + (size_t)row * D) + lane;
#pragma unroll
        for (int j = 0; j < 8; ++j) o4[64 * j] = v[j] * rstd * g4[64 * j];
    } else {
        if (MODE == 0 || MODE == 1) { f32x4* o4 = (f32x4*)(h + (size_t)row * D) + lane;
#pragma unroll
            for (int j = 0; j < 8; ++j) o4[64 * j] = v[j]; }
        u32x2* a2 = (u32x2*)(abf + (size_t)row * D) + lane;
#pragma unroll
        for (int j = 0; j < 8; ++j) { const f32x4 o = v[j] * rstd * g4[64 * j]; u32x2 w; w.x = pk2(o[0], o[1]); w.y = pk2(o[2], o[3]); a2[64 * j] = w; }
    }
}

__device__ __forceinline__ void dot2(const bf16_t* __restrict__ arow, int K, const float* __restrict__ p0, const float* __restrict__ p1, int ld, float& v0, float& v1) {
    float a0 = 0.f, a1 = 0.f;
    for (int k = 0; k < K; k += 8) {
        const u32x4 av = *(const u32x4*)(arow + k);
        const unsigned w[4] = {av.x, av.y, av.z, av.w};
#pragma unroll
        for (int j = 0; j < 4; ++j) {
            const float x0 = __uint_as_float(w[j] << 16), x1 = __uint_as_float(w[j] & 0xffff0000u);
            const size_t o0 = (size_t)(k + 2 * j) * ld, o1 = o0 + ld;
            a0 = fmaf(x0, p0[o0], a0); a1 = fmaf(x0, p1[o0], a1);
            a0 = fmaf(x1, p0[o1], a0); a1 = fmaf(x1, p1[o1], a1);
        }
    }
    v0 = a0; v1 = a1;
}

__global__ void k_n_mla_a(const bf16_t* abf, const float* wdq, const float* wdkv, bf16_t* raw) {
    const int c = blockIdx.x * 256 + threadIdx.x, row = blockIdx.y; if (c >= 544) return;
    const int n = 2 * c; const float* p; int ld;
    if (n < 512) { p = wdq + n; ld = 512; } else { p = wdkv + (n - 512); ld = 576; }
    float v0, v1; dot2(abf + (size_t)row * D, D, p, p + 1, ld, v0, v1);
    *(unsigned*)(raw + (size_t)row * 1280 + n) = pk2(v0, v1);
}
__global__ void __launch_bounds__(512) k_mla_prep(const bf16_t* raw, const float* qn, const float* kvn, const float2* cs, bf16_t* cq, bf16_t* ckv, bf16_t* kr) {
    const int row = blockIdx.x * 8 + (threadIdx.x >> 6), lane = threadIdx.x & 63;
    const bf16_t* r = raw + (size_t)row * 1280;
#pragma unroll
    for (int part = 0; part < 2; ++part) {
        const u32x4 v = *(const u32x4*)(r + part * 512 + 8 * lane); const unsigned w[4] = {v.x, v.y, v.z, v.w};
        float x[8]; float ss = 0.f;
#pragma unroll
        for (int j = 0; j < 4; ++j) { x[2 * j] = __uint_as_float(w[j] << 16); x[2 * j + 1] = __uint_as_float(w[j] & 0xffff0000u); ss += x[2 * j] * x[2 * j] + x[2 * j + 1] * x[2 * j + 1]; }
        const float rstd = 1.0f / sqrtf(wave_sum(ss) * (1.0f / 512.0f) + EPS);
        const float* g = (part ? kvn : qn) + 8 * lane;
        u32x4 o; o.x = pk2(x[0] * rstd * g[0], x[1] * rstd * g[1]); o.y = pk2(x[2] * rstd * g[2], x[3] * rstd * g[3]); o.z = pk2(x[4] * rstd * g[4], x[5] * rstd * g[5]); o.w = pk2(x[6] * rstd * g[6], x[7] * rstd * g[7]);
        *(u32x4*)((part ? ckv : cq) + (size_t)row * 512 + 8 * lane) = o;
    }
    if (lane < 32) {
        const float x1 = bf2f(r[1024 + lane]), x2 = bf2f(r[1024 + 32 + lane]); const float2 c = cs[(size_t)row * 32 + lane];
        *(unsigned*)(kr + (size_t)row * 64 + 2 * lane) = pk2(x1 * c.x - x2 * c.y, x2 * c.x + x1 * c.y);
    }
}
__global__ void k_n_mla_uq(const bf16_t* cq, const float* wuq, const float2* cs, bf16_t* Qn, bf16_t* Qr) {
    const int c = blockIdx.x * 256 + threadIdx.x, row = blockIdx.y;
    float v0, v1;
    if (c < 1024) { const int n = 2 * c, hh = n >> 7, d = n & 127; const float* p = wuq + hh * 192 + d;
        dot2(cq + (size_t)row * 512, 512, p, p + 1, 3072, v0, v1);
        *(unsigned*)(Qn + (size_t)row * 2048 + n) = pk2(v0 * QS_MLA, v1 * QS_MLA);
    } else { const int ci = c - 1024, hh = ci >> 5, i = ci & 31; const float* p = wuq + hh * 192 + 128 + i;
        dot2(cq + (size_t)row * 512, 512, p, p + 32, 3072, v0, v1);
        const float2 t = cs[(size_t)row * 32 + i];
        *(unsigned*)(Qr + (size_t)row * 1024 + hh * 64 + 2 * i) = pk2((v0 * t.x - v1 * t.y) * QS_MLA, (v1 * t.x + v0 * t.y) * QS_MLA);
    }
}
__global__ void k_n_mla_ukv(const bf16_t* ckv, const float* wukv, bf16_t* Kn, bf16_t* V) {
    const int c = blockIdx.x * 256 + threadIdx.x, row = blockIdx.y;
    const int n = 2 * c, which = n >> 11, nn = n & 2047, hh = nn >> 7, d = nn & 127; const float* p = wukv + hh * 256 + which * 128 + d;
    float v0, v1; dot2(ckv + (size_t)row * 512, 512, p, p + 1, 4096, v0, v1);
    *(unsigned*)((which ? V : Kn) + (size_t)row * 2048 + nn) = pk2(v0, v1);
}
__global__ void k_n_wo(const bf16_t* O, const float* wo, float* h) {
    const int c = blockIdx.x * 256 + threadIdx.x, row = blockIdx.y;
    const int n = 2 * c; float v0, v1; dot2(O + (size_t)row * D, D, wo + n, wo + n + 1, D, v0, v1);
    float2* hp = (float2*)(h + (size_t)row * D + n); float2 x = *hp; x.x += v0; x.y += v1; *hp = x;
}
__global__ void k_n_fox_a(const bf16_t* abf, const float* wqkv, const float* wog, const float* wf, const float* bfv, bf16_t* Q, bf16_t* K, bf16_t* V, bf16_t* G, float* logf) {
    const int c = blockIdx.x * 256 + threadIdx.x, row = blockIdx.y; if (c >= 4104) return;
    const int n = 2 * c; float v0, v1; const bf16_t* a = abf + (size_t)row * D;
    if (n < 6144) { dot2(a, D, wqkv + n, wqkv + n + 1, 6144, v0, v1); bf16_t* o = (n < 2048 ? Q : (n < 4096 ? K : V)); *(unsigned*)(o + (size_t)row * 2048 + (n & 2047)) = pk2(v0, v1); }
    else if (n < 8192) { const int m = n - 6144; dot2(a, D, wog + m, wog + m + 1, 2048, v0, v1); *(unsigned*)(G + (size_t)row * 2048 + m) = pk2(1.0f / (1.0f + expf(-v0)), 1.0f / (1.0f + expf(-v1))); }
    else { const int m = n - 8192; dot2(a, D, wf + m, wf + m + 1, 16, v0, v1); v0 += bfv[m]; v1 += bfv[m + 1];
        logf[(size_t)row * 16 + m] = fminf(v0, 0.f) - log1pf(expf(-fabsf(v0))); logf[(size_t)row * 16 + m + 1] = fminf(v1, 0.f) - log1pf(expf(-fabsf(v1))); }
}
__global__ void __launch_bounds__(512) k_fox_qknorm(bf16_t* Q, bf16_t* K, const float* gq, const float* gk) {
    const int row = blockIdx.x * 8 + (threadIdx.x >> 6), lane = threadIdx.x & 63;
#pragma unroll
    for (int part = 0; part < 2; ++part) {
        bf16_t* p = (part ? K : Q) + (size_t)row * 2048 + 32 * lane; const float* g = (part ? gk : gq) + 32 * (lane & 3);
        u32x4 v[4]; float ss = 0.f;
#pragma unroll
        for (int j = 0; j < 4; ++j) { v[j] = *(const u32x4*)(p + 8 * j); const unsigned w[4] = {v[j].x, v[j].y, v[j].z, v[j].w};
#pragma unroll
            for (int e = 0; e < 4; ++e) { const float a = __uint_as_float(w[e] << 16), b = __uint_as_float(w[e] & 0xffff0000u); ss += a * a + b * b; } }
        ss += __shfl_xor(ss, 1); ss += __shfl_xor(ss, 2);
        const float sc = (1.0f / sqrtf(ss * (1.0f / 128.0f) + EPS)) * (part ? 1.0f : QS_FOX);
#pragma unroll
        for (int j = 0; j < 4; ++j) { const unsigned w[4] = {v[j].x, v[j].y, v[j].z, v[j].w}; unsigned o[4];
#pragma unroll
            for (int e = 0; e < 4; ++e) { const float a = __uint_as_float(w[e] << 16), b = __uint_as_float(w[e] & 0xffff0000u); o[e] = pk2(a * sc * g[8 * j + 2 * e], b * sc * g[8 * j + 2 * e + 1]); }
            u32x4 ov; ov.x = o[0]; ov.y = o[1]; ov.z = o[2]; ov.w = o[3]; *(u32x4*)(p + 8 * j) = ov; }
    }
}
__global__ void __launch_bounds__(64) k_fox_scan(const float* logf, float* nck) {
    const int bh = blockIdx.x, b = bh / NH, hh = bh % NH, lane = threadIdx.x;
    const float* src = logf + ((size_t)b * S + 64 * lane) * 16 + hh;
    float tot = 0.f; for (int i = 0; i < 64; ++i) tot += src[(size_t)i * 16];
    float inc = tot;
#pragma unroll
    for (int o = 1; o < 64; o <<= 1) { const float t = __shfl_up(inc, o); if (lane >= o) inc += t; }
    float run = inc - tot;
    float* dst = nck + (size_t)bh * S + 64 * lane;
    for (int i = 0; i < 64; ++i) { run += src[(size_t)i * 16]; dst[i] = -run * LOG2E; }
}

template <int MODE  >
__global__ void __launch_bounds__(512) k_nattn(const bf16_t* Qn, const bf16_t* Qr, const bf16_t* Kn, const bf16_t* Kr, const bf16_t* V, const float* nck, const bf16_t* gate, bf16_t* O) {
    __shared__ float qs[8][192];
    const int wv = threadIdx.x >> 6, lane = threadIdx.x & 63;
    const int idx = blockIdx.x * 8 + wv, s = idx % S, bh = idx / S, b = bh / NH, hh = bh % NH;
    const size_t tq = (size_t)b * S + s;
    for (int d = lane; d < 128; d += 64) qs[wv][d] = bf2f(Qn[tq * 2048 + hh * 128 + d]);
    if (MODE == 0) qs[wv][128 + lane] = bf2f(Qr[tq * 1024 + hh * 64 + lane]);
    __syncthreads();
    const int nkeys = MODE == 0 ? ((s | 63) + 1) : s + 1;
    float m = -1e30f, l = 0.f, o0 = 0.f, o1 = 0.f;
    for (int base = 0; base < nkeys; base += 64) {
        const int j = base + lane; const bool valid = j < nkeys;
        float dot = -__builtin_inff();
        if (valid) {
            const size_t tk = (size_t)b * S + j;
            const u32x4* kp = (const u32x4*)(Kn + tk * 2048 + hh * 128);
            dot = 0.f;
#pragma unroll
            for (int c = 0; c < 16; ++c) { const u32x4 kv = kp[c]; const unsigned w[4] = {kv.x, kv.y, kv.z, kv.w};
#pragma unroll
                for (int e = 0; e < 4; ++e) dot += qs[wv][8 * c + 2 * e] * __uint_as_float(w[e] << 16) + qs[wv][8 * c + 2 * e + 1] * __uint_as_float(w[e] & 0xffff0000u); }
            if (MODE == 0) { const u32x4* rp = (const u32x4*)(Kr + tk * 64);
#pragma unroll
                for (int c = 0; c < 8; ++c) { const u32x4 kv = rp[c]; const unsigned w[4] = {kv.x, kv.y, kv.z, kv.w};
#pragma unroll
                    for (int e = 0; e < 4; ++e) dot += qs[wv][128 + 8 * c + 2 * e] * __uint_as_float(w[e] << 16) + qs[wv][128 + 8 * c + 2 * e + 1] * __uint_as_float(w[e] & 0xffff0000u); } }
            if (MODE == 1) dot += nck[(size_t)bh * S + j];
        }
        const float mn = fmaxf(m, wave_max(dot)), alpha = exp2f(m - mn), p = valid ? exp2f(dot - mn) : 0.f;
        l = l * alpha + p; o0 *= alpha; o1 *= alpha; m = mn;
        const int nk = (nkeys - base) < 64 ? (nkeys - base) : 64;
        const bf16_t* vb = V + ((size_t)b * S + base) * 2048 + hh * 128 + lane;
        for (int jj = 0; jj < nk; ++jj) { const float pj = __shfl(p, jj); o0 += pj * bf2f(vb[(size_t)jj * 2048]); o1 += pj * bf2f(vb[(size_t)jj * 2048 + 64]); }
    }
    const float inv = 1.0f / wave_sum(l);
    float g0 = 1.f, g1 = 1.f;
    if (MODE == 1) { g0 = bf2f(gate[tq * 2048 + hh * 128 + lane]); g1 = bf2f(gate[tq * 2048 + hh * 128 + 64 + lane]); }
    O[tq * 2048 + hh * 128 + lane] = (bf16_t)f2bf(o0 * inv * g0);
    O[tq * 2048 + hh * 128 + 64 + lane] = (bf16_t)f2bf(o1 * inv * g1);
}

__global__ void __launch_bounds__(512) k_n_router(const float* h, const float* gain, const float* wg, const float* bg, const float* wr, const float* br,
                                                   bf16_t* abf, unsigned* cnt, int* rowlist, float* roww) {
    const int row = blockIdx.x * 8 + (threadIdx.x >> 6), lane = threadIdx.x & 63;
    const f32x4* s4 = (const f32x4*)(h + (size_t)row * D) + lane; const f32x4* g4 = (const f32x4*)gain + lane;
    f32x4 v[8]; float ss = 0.f;
#pragma unroll
    for (int j = 0; j < 8; ++j) { v[j] = s4[64 * j]; ss += (v[j][0] * v[j][0] + v[j][1] * v[j][1]) + (v[j][2] * v[j][2] + v[j][3] * v[j][3]); }
    const float rstd = 1.0f / sqrtf(wave_sum(ss) * (1.0f / D) + EPS);
    u32x2* a2 = (u32x2*)(abf + (size_t)row * D) + lane;
#pragma unroll
    for (int j = 0; j < 8; ++j) { v[j] = v[j] * rstd * g4[64 * j]; u32x2 w; w.x = pk2(v[j][0], v[j][1]); w.y = pk2(v[j][2], v[j][3]); a2[64 * j] = w; }
    float lg[40];
#pragma unroll
    for (int c = 0; c < 40; ++c) lg[c] = 0.f;
#pragma unroll
    for (int j = 0; j < 8; ++j)
#pragma unroll
        for (int e = 0; e < 4; ++e) { const int k = 4 * lane + 256 * j + e; const float x = v[j][e];
            const f32x4* pg = (const f32x4*)(wg + (size_t)k * 8); const f32x4* pr = (const f32x4*)(wr + (size_t)k * 32);
#pragma unroll
            for (int q = 0; q < 2; ++q) { const f32x4 w = pg[q]; lg[4 * q] += x * w[0]; lg[4 * q + 1] += x * w[1]; lg[4 * q + 2] += x * w[2]; lg[4 * q + 3] += x * w[3]; }
#pragma unroll
            for (int q = 0; q < 8; ++q) { const f32x4 w = pr[q]; lg[8 + 4 * q] += x * w[0]; lg[8 + 4 * q + 1] += x * w[1]; lg[8 + 4 * q + 2] += x * w[2]; lg[8 + 4 * q + 3] += x * w[3]; } }
#pragma unroll
    for (int c = 0; c < 40; ++c) lg[c] = wave_sum(lg[c]);
    float gl[8]; float gmax = -3.0e38f; int gs = 0;
#pragma unroll
    for (int c = 0; c < 8; ++c) { gl[c] = lg[c] + bg[c]; if (gl[c] > gmax) { gmax = gl[c]; gs = c; } }
    float gsum = 0.f;
#pragma unroll
    for (int c = 0; c < 8; ++c) gsum += expf(gl[c] - gmax);
    const float gw = 1.0f / gsum;
    float el[4];
#pragma unroll
    for (int j = 0; j < 4; ++j) { float x = 0.f;
#pragma unroll
        for (int g = 0; g < 8; ++g) x = (g == gs) ? lg[8 + 4 * g + j] + br[4 * g + j] : x;
        el[j] = x; }
    int j1 = 0; float m1 = el[0];
#pragma unroll
    for (int j = 1; j < 4; ++j) if (el[j] > m1) { m1 = el[j]; j1 = j; }
    int j2 = -1; float m2 = -3.0e38f;
#pragma unroll
    for (int j = 0; j < 4; ++j) if (j != j1 && el[j] > m2) { m2 = el[j]; j2 = j; }
    const float e2 = expf(m2 - m1), w1 = gw / (1.0f + e2), w2 = gw * e2 / (1.0f + e2);
    if (lane < 2) { const int e = gs * 4 + (lane == 0 ? j1 : j2); const float w = lane == 0 ? w1 : w2;
        const unsigned r = atomicAdd(cnt + e, 1u); rowlist[e * ECAP + r] = row * 2 + lane; roww[e * ECAP + r] = w; }
}
__device__ __forceinline__ bool moe_locate(const unsigned* cnt, int gr, int& e, int& r) {
    int off = 0;
    for (int i = 0; i < NE; ++i) { const int c = (int)cnt[i], p = (c + 255) & ~255; if (gr < off + p) { e = i; r = gr - off; return r < c; } off += p; }
    e = 0; r = 0; return false;
}
__global__ void k_n_moe_gu(const bf16_t* abf, const float* wgate, const float* wup, const unsigned* cnt, const int* rowlist, bf16_t* hid) {
    const int c = blockIdx.y * 256 + threadIdx.x, gr = blockIdx.x;
    int e, r; if (!moe_locate(cnt, gr, e, r)) return;
    const int tok = rowlist[e * ECAP + r] >> 1;
    float v0, v1; dot2(abf + (size_t)tok * D, D, wgate + (size_t)e * D * FF + c, wup + (size_t)e * D * FF + c, FF, v0, v1);
    hid[(size_t)gr * FF + c] = (bf16_t)f2bf(v0 / (1.0f + expf(-v0)) * v1);
}
__global__ void k_n_moe_d(const bf16_t* hid, const float* wdown, const unsigned* cnt, const int* rowlist, const float* roww, bf16_t* y2) {
    const int c = blockIdx.y * 256 + threadIdx.x, gr = blockIdx.x;
    int e, r; if (!moe_locate(cnt, gr, e, r)) return;
    const int dst = rowlist[e * ECAP + r]; const float w = roww[e * ECAP + r];
    const int n = 2 * c; float v0, v1; dot2(hid + (size_t)gr * FF, FF, wdown + (size_t)e * FF * D + n, wdown + (size_t)e * FF * D + n + 1, D, v0, v1);
    *(unsigned*)(y2 + (size_t)dst * D + n) = pk2(v0 * w, v1 * w);
}

#define LAS __attribute__((address_space(3)))
#define GAS __attribute__((address_space(1)))
typedef short bf16x8 __attribute__((ext_vector_type(8)));
typedef GAS unsigned gu32;
#define RLX_AGENT __ATOMIC_RELAXED, __HIP_MEMORY_SCOPE_AGENT
__device__ __forceinline__ int lane_id_v() { int l; asm volatile("v_mbcnt_lo_u32_b32 %0, -1, 0\n\tv_mbcnt_hi_u32_b32 %0, -1, %0" : "=v"(l)); return l; }
#define LDS_WAIT() asm volatile("s_waitcnt lgkmcnt(0)" ::: "memory")
#define VM_WAIT() asm volatile("s_waitcnt vmcnt(0)" ::: "memory")

constexpr size_t WS_W_MLA_A = 32 * MiB;
constexpr size_t WS_W_MLA_UQ = 42 * MiB;
constexpr size_t WS_W_MLA_UKV = 48 * MiB;
constexpr size_t WS_W_MLA_O = 56 * MiB;
constexpr size_t WS_W_FOX_A = 72 * MiB;
constexpr size_t WS_W_FOX_O = 138 * MiB;
constexpr size_t WS_W_GU = 154 * MiB;
constexpr size_t WS_W_D = 666 * MiB;
static_assert(WS_W_D + 128ull * 2048 * 512 * 2 <= WS_ABF, "weights map");
constexpr size_t WS_WRT = 28 * MiB;
constexpr int CW_BAR = 4096;
constexpr int CW_TMO = 0;

constexpr int LDS_CTL_BYTES = 1024;
constexpr int RING_OFF = 1024, RING_BYTES = 131072;
constexpr int LDS_BYTES = 147456;

namespace pg8 {
constexpr int BM = 256, BK = 64, HALF = 128, HTB = HALF * BK * 2, STAGE_BYTES = 8 * HTB, NXCD = 8, WGM = 8;
__host__ __device__ __forceinline__ int lds_byte(int r, int c) { const int st = (r >> 4) * 2 + (c >> 5), rr = r & 15, cc = c & 31, ob = rr * 64 + cc * 2; return st * 1024 + (ob ^ (((ob >> 9) & 1) << 5)); }
__host__ __device__ __forceinline__ void stage_rc(int b, int& R, int& C) { const int st = b / 1024, sb = b % 1024, swz = sb ^ (((sb >> 9) & 1) << 5); R = (st >> 1) * 16 + swz / 64; C = (st & 1) * 32 + (swz % 64) / 2; }
__host__ __device__ __forceinline__ int perm32(int rho) { const int n = rho >> 4, i = rho & 15; return 8 * (i >> 2) + 4 * n + (i & 3); }

struct Unit { int pm, pn, e, r0; };
struct Gemm { const bf16_t* A; const bf16_t* Bt; int K; size_t bstride_e; };

struct StaticOrder {
    int nM, nN, nwg, G, c;
    __device__ void init(int M, int N, int G_, int c_) { nM = M / BM; nN = N / BM; nwg = nM * nN; G = G_; c = c_; }
    __device__ bool next(int i, Unit& u) const {
        const long L = (long)i * G + c; if (L >= nwg) return false;
        int wgid = (int)L; { const int q = nwg / NXCD, r = nwg % NXCD, xcd = wgid % NXCD, off = wgid / NXCD; wgid = (xcd < r ? xcd * (q + 1) : r * (q + 1) + (xcd - r) * q) + off; }
        const int nig = WGM * nN, gid = wgid / nig, fm = gid * WGM, gsz = (nM - fm) < WGM ? (nM - fm) : WGM;
        u.pm = fm + ((wgid % nig) % gsz); u.pn = (wgid % nig) / gsz; u.e = 0; u.r0 = 0; return true;
    }
    __device__ __forceinline__ void gather(const Unit&, unsigned (&)[2][2], const int (&)[2], const int (&)[2], int) const {}
};
struct MoeOrder {
    const LAS int* pre;
    const int* rowlist; const unsigned* cnt; int nN, nU, G, c;
    __device__ void init(const LAS int* pre_, const int* rl, const unsigned* cnt_, int nN_, int G_, int c_) { pre = pre_; rowlist = rl; cnt = cnt_; nN = nN_; nU = pre_[NE] * nN_; G = G_; c = c_; }
    __device__ bool next(int i, Unit& u) const {
        const int perX = (nU + NXCD - 1) / NXCD, x = c % NXCD, k = i * (G / NXCD) + c / NXCD;
        if (k >= perX) return false; const int L = x * perX + k; if (L >= nU) return false;
        const int g = L / nN; u.pn = L - g * nN; int e = 0;
#pragma unroll 1
        for (int j = 16; j >= 1; j >>= 1) if (pre[e + j] <= g) e += j;
        u.e = e; u.pm = g; u.r0 = (g - pre[e]) * BM; return true;
    }
    __device__ __forceinline__ void gather(const Unit& u, unsigned (&v)[2][2], const int (&R)[2], const int (&C)[2], int K) const {
        const int n = (int)cnt[u.e];
#pragma unroll
        for (int h = 0; h < 2; ++h)
#pragma unroll
            for (int i = 0; i < 2; ++i) { const int r = u.r0 + h * HALF + R[i]; const int tok = r < n ? (rowlist[u.e * ECAP + r] >> 1) : 0; v[h][i] = (unsigned)(tok * K + C[i]) * 2u; }
    }
};

__device__ __forceinline__ unsigned cvt_pk_bf16(float lo, float hi) { unsigned r; asm volatile("v_cvt_pk_bf16_f32 %0, %1, %2" : "=v"(r) : "v"(lo), "v"(hi)); return r; }
__device__ __forceinline__ float fsigmoid(float x) { return __builtin_amdgcn_rcpf(1.0f + __builtin_amdgcn_exp2f(-x * LOG2E)); }

typedef const f32x4 (&AccRef)[2][2][4][2];
#define EPI_ROWS(ai, m) (u.pm * BM + (ai) * HALF + wr * 64 + (m) * 16 + fr)
__device__ __forceinline__ u32x4 pack8s(f32x4 a, f32x4 b, float s) { u32x4 w; w.x = cvt_pk_bf16(a[0] * s, a[1] * s); w.y = cvt_pk_bf16(a[2] * s, a[3] * s); w.z = cvt_pk_bf16(b[0] * s, b[1] * s); w.w = cvt_pk_bf16(b[2] * s, b[3] * s); return w; }

struct EpiBf16S {
    static constexpr bool PERM = true;
    bf16_t* O; int ldc; int split_cols; size_t split_stride; float scale;
    __device__ __forceinline__ void operator()(AccRef acc, const Unit& u, int wr, int wc, int fr, int fq) const {
        int colt = u.pn * BM; bf16_t* base = O; if (split_cols) { const int t = colt / split_cols; base += (size_t)t * split_stride; colt -= t * split_cols; }
        const int col0 = colt + wc * 32 + 8 * fq;
#pragma unroll
        for (int ai = 0; ai < 2; ++ai)
#pragma unroll
            for (int m = 0; m < 4; ++m) { bf16_t* rowp = base + (size_t)EPI_ROWS(ai, m) * ldc + col0;
#pragma unroll
                for (int bj = 0; bj < 2; ++bj) *(u32x4*)(rowp + bj * HALF) = pack8s(acc[ai][bj][m][0], acc[ai][bj][m][1], scale); }
    }
};
struct EpiMlaQ {
    static constexpr bool PERM = true;
    bf16_t* Qn; bf16_t* Qr; const float* cs;
    __device__ __forceinline__ void operator()(AccRef acc, const Unit& u, int wr, int wc, int fr, int fq) const {
        if (u.pn < 8) { const int col0 = u.pn * BM + wc * 32 + 8 * fq;
#pragma unroll
            for (int ai = 0; ai < 2; ++ai)
#pragma unroll
                for (int m = 0; m < 4; ++m) { bf16_t* rowp = Qn + (size_t)EPI_ROWS(ai, m) * 2048 + col0;
#pragma unroll
                    for (int bj = 0; bj < 2; ++bj) *(u32x4*)(rowp + bj * HALF) = pack8s(acc[ai][bj][m][0], acc[ai][bj][m][1], QS_MLA); }
        } else { const int col0 = (u.pn - 8) * BM + wc * 32 + 8 * fq;
#pragma unroll
            for (int ai = 0; ai < 2; ++ai)
#pragma unroll
                for (int m = 0; m < 4; ++m) { const int row = EPI_ROWS(ai, m); bf16_t* rowp = Qr + (size_t)row * 1024 + col0;
#pragma unroll
                    for (int bj = 0; bj < 2; ++bj) { const int i0 = ((col0 + bj * HALF) & 63) >> 1; const f32x4* cp = (const f32x4*)(cs + ((size_t)row * 32 + i0) * 2);
                        const f32x4 ca = cp[0], cb = cp[1], a = acc[ai][bj][m][0], b = acc[ai][bj][m][1]; f32x4 ra, rb;
                        ra[0] = a[0] * ca[0] - a[1] * ca[1]; ra[1] = a[1] * ca[0] + a[0] * ca[1]; ra[2] = a[2] * ca[2] - a[3] * ca[3]; ra[3] = a[3] * ca[2] + a[2] * ca[3];
                        rb[0] = b[0] * cb[0] - b[1] * cb[1]; rb[1] = b[1] * cb[0] + b[0] * cb[1]; rb[2] = b[2] * cb[2] - b[3] * cb[3]; rb[3] = b[3] * cb[2] + b[2] * cb[3];
                        *(u32x4*)(rowp + bj * HALF) = pack8s(ra, rb, QS_MLA); } }
        }
    }
};
struct EpiFoxA {
    static constexpr bool PERM = true;
    bf16_t* O; size_t stride; float* logf; const float* bfv;
    __device__ __forceinline__ void operator()(AccRef acc, const Unit& u, int wr, int wc, int fr, int fq) const {
        if (u.pn < 32) { const int t = u.pn >> 3; bf16_t* base = O + (size_t)t * stride; const int col0 = (u.pn & 7) * BM + wc * 32 + 8 * fq; const bool sg = t == 3;
#pragma unroll
            for (int ai = 0; ai < 2; ++ai)
#pragma unroll
                for (int m = 0; m < 4; ++m) { bf16_t* rowp = base + (size_t)EPI_ROWS(ai, m) * 2048 + col0;
#pragma unroll
                    for (int bj = 0; bj < 2; ++bj) { f32x4 a = acc[ai][bj][m][0], b = acc[ai][bj][m][1];
                        if (sg) {
#pragma unroll
                            for (int e = 0; e < 4; ++e) { a[e] = fsigmoid(a[e]); b[e] = fsigmoid(b[e]); } }
                        *(u32x4*)(rowp + bj * HALF) = pack8s(a, b, 1.0f); } }
        } else if (wc == 0 && fq < 2) {
#pragma unroll
            for (int ai = 0; ai < 2; ++ai)
#pragma unroll
                for (int m = 0; m < 4; ++m) { float* rowp = logf + (size_t)EPI_ROWS(ai, m) * 16 + 8 * fq;
#pragma unroll
                    for (int n = 0; n < 2; ++n) { f32x4 a = acc[ai][0][m][n]; const f32x4 bb = *(const f32x4*)(bfv + 8 * fq + 4 * n);
#pragma unroll
                        for (int e = 0; e < 4; ++e) { const float x = a[e] + bb[e]; a[e] = fminf(x, 0.f) - log1pf(expf(-fabsf(x))); }
                        *(f32x4*)(rowp + 4 * n) = a; } }
        }
    }
};
struct EpiRes {
    static constexpr bool PERM = true;
    float* h;
    __device__ __forceinline__ void operator()(AccRef acc, const Unit& u, int wr, int wc, int fr, int fq) const {
        const int col0 = u.pn * BM + wc * 32 + 8 * fq;
#pragma unroll
        for (int ai = 0; ai < 2; ++ai)
#pragma unroll
            for (int m = 0; m < 4; ++m) { float* rowp = h + (size_t)EPI_ROWS(ai, m) * D + col0;
#pragma unroll
                for (int bj = 0; bj < 2; ++bj) { f32x4* p = (f32x4*)(rowp + bj * HALF); p[0] = p[0] + acc[ai][bj][m][0]; p[1] = p[1] + acc[ai][bj][m][1]; } }
    }
};
struct EpiGU {
    static constexpr bool PERM = true;
    bf16_t* hid;
    __device__ __forceinline__ void operator()(AccRef acc, const Unit& u, int wr, int wc, int fr, int fq) const {
        const int col0 = u.pn * HALF + wc * 32 + 8 * fq;
#pragma unroll
        for (int ai = 0; ai < 2; ++ai)
#pragma unroll
            for (int m = 0; m < 4; ++m) { f32x4 o[2];
#pragma unroll
                for (int n = 0; n < 2; ++n)
#pragma unroll
                    for (int e = 0; e < 4; ++e) { const float g = acc[ai][0][m][n][e]; o[n][e] = g * fsigmoid(g) * acc[ai][1][m][n][e]; }
                *(u32x4*)(hid + (size_t)EPI_ROWS(ai, m) * FF + col0) = pack8s(o[0], o[1], 1.0f); }
    }
};
struct EpiDown {
    static constexpr bool PERM = true;
    bf16_t* y2; const int* rowlist; const float* roww; const unsigned* cnt;
    __device__ __forceinline__ void operator()(AccRef acc, const Unit& u, int wr, int wc, int fr, int fq) const {
        const int col0 = u.pn * BM + wc * 32 + 8 * fq, n = (int)cnt[u.e];
#pragma unroll
        for (int ai = 0; ai < 2; ++ai)
#pragma unroll
            for (int m = 0; m < 4; ++m) { const int r = u.r0 + ai * HALF + wr * 64 + m * 16 + fr;
                if (r < n) { const int dst = rowlist[u.e * ECAP + r]; const float w = roww[u.e * ECAP + r]; bf16_t* rowp = y2 + (size_t)dst * D + col0;
#pragma unroll
                    for (int bj = 0; bj < 2; ++bj) *(u32x4*)(rowp + bj * HALF) = pack8s(acc[ai][bj][m][0], acc[ai][bj][m][1], w); } }
    }
};

template <class Epi, class Sched, bool GATHER>
__device__ __forceinline__ void gemm_phase(LAS unsigned char* lds, const Gemm g, const Sched& S, const Epi& E, const int wv) {
    const int tid = wv * 64 + lane_id_v();
    const int wid = __builtin_amdgcn_readfirstlane(tid >> 6), lane = tid & 63, wr = wid >> 2, wc = wid & 3, fr = lane & 15, fq = lane >> 4;
    const int K = g.K, nt = K / BK;
    int sR[2], sC[2]; unsigned voffB[2], vA[2][2], vAn[2][2];
#pragma unroll
    for (int i = 0; i < 2; ++i) { stage_rc(tid * 16 + i * 8192, sR[i], sC[i]); const int Rb = Epi::PERM ? ((sR[i] & ~31) + perm32(sR[i] & 31)) : sR[i];
        voffB[i] = (unsigned)(Rb * K + sC[i]) * 2u;
#pragma unroll
        for (int h = 0; h < 2; ++h) { vA[h][i] = (unsigned)((h * HALF + sR[i]) * K + sC[i]) * 2u; vAn[h][i] = vA[h][i]; } }
    const size_t kstep = (size_t)(BK * 2), hstep = (size_t)HALF * K * 2, tstep = 2 * hstep;
    const unsigned ldsw = (unsigned)wid * 1024u;
    const int aoff = lds_byte(wr * 64 + fr, fq * 8), boff = lds_byte(wc * 32 + fr, fq * 8);
#define PG8_SA(b, h) (((b) * 2 + (h)) * HTB)
#define PG8_SB(b, h) ((4 + (b) * 2 + (h)) * HTB)
#define PG8_STAGE(bufoff, gbase, voff) do { _Pragma("unroll") for (int _i = 0; _i < 2; ++_i) \
        __builtin_amdgcn_global_load_lds((const unsigned*)((const char*)(gbase) + (voff)[_i]), (LAS unsigned*)(lds + (bufoff) + ldsw + _i * 8192), 16, 0, 0); } while (0)
#define PG8_LDA(dst, b, h) do { _Pragma("unroll") for (int m = 0; m < 4; ++m) _Pragma("unroll") for (int k = 0; k < 2; ++k) dst[m][k] = *(const LAS bf16x8*)(lds + PG8_SA(b, h) + aoff + m * 2048 + k * 1024); } while (0)
#define PG8_LDB(dst, b, h) do { _Pragma("unroll") for (int n = 0; n < 2; ++n) _Pragma("unroll") for (int k = 0; k < 2; ++k) dst[n][k] = *(const LAS bf16x8*)(lds + PG8_SB(b, h) + boff + n * 2048 + k * 1024); } while (0)
#define PG8_MMA(ai, bj, At, Bt) do { __builtin_amdgcn_s_setprio(1); _Pragma("unroll") for (int m = 0; m < 4; ++m) _Pragma("unroll") for (int n = 0; n < 2; ++n) _Pragma("unroll") for (int k = 0; k < 2; ++k) \
        acc[ai][bj][m][n] = __builtin_amdgcn_mfma_f32_16x16x32_bf16(Bt[n][k], At[m][k], acc[ai][bj][m][n], 0, 0, 0); __builtin_amdgcn_s_setprio(0); } while (0)
#define PG8_WAIT_V(n) asm volatile("s_waitcnt vmcnt(" #n ")" ::: "memory")
#define PG8_WAIT_L(n) asm volatile("s_waitcnt lgkmcnt(" #n ")" ::: "memory")
#define PG8_BAR __builtin_amdgcn_s_barrier()
#define PG8_SCHED __builtin_amdgcn_sched_barrier(0)
    Unit cur, nxt; int ui = 0;
    if (!S.next(0, cur)) return;
    f32x4 acc[2][2][4][2];
#pragma unroll
    for (int a = 0; a < 2; ++a)
#pragma unroll
        for (int b = 0; b < 2; ++b)
#pragma unroll
            for (int m = 0; m < 4; ++m)
#pragma unroll
                for (int n = 0; n < 2; ++n) acc[a][b][m][n] = (f32x4){0.f, 0.f, 0.f, 0.f};
    bf16x8 At[4][2], B0[2][2], B1[2][2];
    const char* cA = GATHER ? (const char*)g.A : (const char*)g.A + (size_t)cur.pm * tstep;
    const char* cB = (const char*)g.Bt + ((size_t)cur.e * g.bstride_e) * 2 + (size_t)cur.pn * tstep;
    if (GATHER) S.gather(cur, vA, sR, sC, K);
    PG8_STAGE(PG8_SB(0, 0), cB, voffB); PG8_STAGE(PG8_SB(0, 1), cB + hstep, voffB); PG8_STAGE(PG8_SA(0, 0), cA, vA[0]); PG8_STAGE(PG8_SA(0, 1), cA, vA[1]);
    if (wr == 1) PG8_BAR;
    PG8_WAIT_V(2); PG8_BAR;
    PG8_STAGE(PG8_SB(1, 0), cB + kstep, voffB); PG8_STAGE(PG8_SA(1, 0), cA + kstep, vA[0]); PG8_STAGE(PG8_SB(1, 1), cB + hstep + kstep, voffB);
    PG8_WAIT_V(6); PG8_BAR;
    for (;;) {
        const bool has_next = S.next(ui + 1, nxt);
        const char* nA = has_next ? (GATHER ? (const char*)g.A : (const char*)g.A + (size_t)nxt.pm * tstep) : cA;
        const char* nB = has_next ? (const char*)g.Bt + ((size_t)nxt.e * g.bstride_e) * 2 + (size_t)nxt.pn * tstep : cB;
        if (GATHER) { if (has_next) S.gather(nxt, vAn, sR, sC, K); else {
#pragma unroll
            for (int h = 0; h < 2; ++h)
#pragma unroll
                for (int i = 0; i < 2; ++i) vAn[h][i] = vA[h][i]; } }
        for (int t = 0; t < nt; t += 2) {
            const bool last = (t == nt - 2);
            const char* a1 = cA + (size_t)(t + 1) * kstep;
            const char* a2 = last ? nA : cA + (size_t)(t + 2) * kstep; const char* b2 = last ? nB : cB + (size_t)(t + 2) * kstep;
            const char* a3 = a2 + kstep; const char* b3 = b2 + kstep;
            unsigned vs[2][2];
#pragma unroll
            for (int h = 0; h < 2; ++h)
#pragma unroll
                for (int i = 0; i < 2; ++i) vs[h][i] = (GATHER && last) ? vAn[h][i] : vA[h][i];
            PG8_LDB(B0, 0, 0); PG8_LDB(B1, 0, 1); PG8_SCHED; PG8_LDA(At, 0, 0); PG8_STAGE(PG8_SA(1, 1), a1, vA[1]);
            PG8_WAIT_V(8); PG8_WAIT_L(0); PG8_BAR; PG8_MMA(0, 0, At, B0); PG8_MMA(0, 1, At, B1); PG8_BAR; PG8_SCHED;
            PG8_LDA(At, 0, 1); PG8_STAGE(PG8_SB(0, 0), b2, voffB); PG8_STAGE(PG8_SB(0, 1), b2 + hstep, voffB); PG8_STAGE(PG8_SA(0, 0), a2, vs[0]);
            PG8_WAIT_V(8); PG8_WAIT_L(0); PG8_BAR; PG8_MMA(1, 0, At, B0); PG8_MMA(1, 1, At, B1); PG8_BAR; PG8_SCHED;
            PG8_LDB(B0, 1, 0); PG8_LDB(B1, 1, 1); PG8_SCHED; PG8_LDA(At, 1, 0); PG8_STAGE(PG8_SA(0, 1), a2, vs[1]);
            PG8_WAIT_V(8); PG8_WAIT_L(0); PG8_BAR; PG8_MMA(0, 0, At, B0); PG8_MMA(0, 1, At, B1); PG8_BAR; PG8_SCHED;
            PG8_LDA(At, 1, 1); PG8_STAGE(PG8_SB(1, 0), b3, voffB); PG8_STAGE(PG8_SB(1, 1), b3 + hstep, voffB); PG8_STAGE(PG8_SA(1, 0), a3, vs[0]);
            PG8_WAIT_V(8); PG8_WAIT_L(0); PG8_BAR; PG8_MMA(1, 0, At, B0); PG8_MMA(1, 1, At, B1); PG8_BAR; PG8_SCHED;
        }
        if (wr == 0) PG8_BAR;
        E(acc, cur, wr, wc, fr, fq);
        if (!has_next) break;
#pragma unroll
        for (int a = 0; a < 2; ++a)
#pragma unroll
            for (int b = 0; b < 2; ++b)
#pragma unroll
                for (int m = 0; m < 4; ++m)
#pragma unroll
                    for (int n = 0; n < 2; ++n) acc[a][b][m][n] = (f32x4){0.f, 0.f, 0.f, 0.f};
        cur = nxt; cA = nA; cB = nB; ++ui;
        if (GATHER) {
#pragma unroll
            for (int h = 0; h < 2; ++h)
#pragma unroll
                for (int i = 0; i < 2; ++i) vA[h][i] = vAn[h][i]; }
        if (wr == 1) PG8_BAR;
    }
    PG8_WAIT_V(0);
    PG8_BAR;
#undef PG8_SA
#undef PG8_SB
#undef PG8_STAGE
#undef PG8_LDA
#undef PG8_LDB
#undef PG8_MMA
#undef PG8_WAIT_V
#undef PG8_WAIT_L
#undef PG8_BAR
#undef PG8_SCHED
}
}

#define XB_TMO      128
#define XB_XCNT(j)  (256  + 64 * (j))
#define XB_XSUB(j)  (1280 + 64 * (j))
#define XB_XGEN(j)  (2304 + 64 * (j))
#define XB_TOP      3328
#define XB_TOPGEN   3392
#define XCD_BAR_WORDS 3456
#define XB_SPIN_CAP (1u << 18)
__device__ __forceinline__ unsigned xb_ld(unsigned* p)              { return __hip_atomic_load(p, __ATOMIC_RELAXED, __HIP_MEMORY_SCOPE_AGENT); }
__device__ __forceinline__ unsigned xb_add(unsigned* p, unsigned v) { return __hip_atomic_fetch_add(p, v, __ATOMIC_RELAXED, __HIP_MEMORY_SCOPE_AGENT); }
__device__ __forceinline__ unsigned xb_xcc_id() { return (unsigned)__builtin_amdgcn_s_getreg((3 << 11) | 20) & 0xFu; }
#define XB_SPIN(cond, bar) do { unsigned _sp = 0; while (cond) { __builtin_amdgcn_s_sleep(1); \
    if ((++_sp & 255u) == 0u) { if (xb_ld(&(bar)[XB_TMO])) break; if (_sp > XB_SPIN_CAP) { atomicAdd(&(bar)[XB_TMO], 1u); break; } } } } while (0)
struct XcdBarrier { unsigned* bar; unsigned x; volatile LAS unsigned* st; };
__device__ __forceinline__ XcdBarrier xcd_barrier_post(unsigned* bar, volatile LAS unsigned* st, const int wv) {
    XcdBarrier b; b.bar = bar; b.x = xb_xcc_id(); b.st = st;
    if (wv == 0 && lane_id_v() == 0) (void)xb_add(&bar[XB_XCNT(b.x)], 1u);
    return b;
}
__device__ __forceinline__ void xcd_barrier_complete(unsigned* bar, unsigned x, unsigned& nloc, unsigned& nx) {
    const unsigned G = gridDim.x * gridDim.y * gridDim.z;
    unsigned sum, cnt, mine, sp = 0u;
    for (;;) {
        sum = 0u; cnt = 0u; mine = 0u;
#pragma unroll
        for (unsigned j = 0; j < 16; ++j) { const unsigned c = xb_ld(&bar[XB_XCNT(j)]); sum += c; cnt += (c > 0u) ? 1u : 0u; mine = (j == x) ? c : mine; }
        if (sum == G) break;
        __builtin_amdgcn_s_sleep(1);
        if ((++sp & 255u) == 0u) { if (xb_ld(&bar[XB_TMO])) break; if (sp > XB_SPIN_CAP) { atomicAdd(&bar[XB_TMO], 1u); break; } }
    }
    nloc = mine > 0u ? mine : 1u; nx = cnt > 0u ? cnt : 1u;
}
__device__ __forceinline__ void xcd_barrier(const XcdBarrier& b, const int wv) {
    asm volatile("s_waitcnt vmcnt(0)" ::: "memory");
    __syncthreads();
    if (wv == 0 && lane_id_v() == 0) {
        unsigned* bar = b.bar; asm volatile("" : "+s"(bar));
        __builtin_amdgcn_s_waitcnt(0);
        unsigned nloc = b.st[0], nx = b.st[1];
        unsigned bx_ = b.x; asm volatile("" : "+s"(bx_));
        if (nloc == 0u) { xcd_barrier_complete(bar, bx_, nloc, nx); b.st[0] = nloc; b.st[1] = nx; }
        const unsigned old = xb_add(&bar[XB_XSUB(bx_)], 1u);
        const unsigned gen = old / nloc;
        if (old + 1u == (gen + 1u) * nloc) {
            __builtin_amdgcn_fence(__ATOMIC_RELEASE, "agent");
            asm volatile("s_waitcnt vmcnt(0)" ::: "memory");
            const unsigned og = xb_add(&bar[XB_TOP], 1u);
            const unsigned tg = og / nx;
            if (og + 1u == (tg + 1u) * nx) xb_add(&bar[XB_TOPGEN], 1u);
            else XB_SPIN(xb_ld(&bar[XB_TOPGEN]) == tg, bar);
            __builtin_amdgcn_fence(__ATOMIC_ACQUIRE, "agent");
            xb_add(&bar[XB_XGEN(bx_)], 1u);
            asm volatile("s_waitcnt vmcnt(0)" ::: "memory");
        } else {
            XB_SPIN(xb_ld(&bar[XB_XGEN(bx_)]) == gen, bar);
            __builtin_amdgcn_fence(__ATOMIC_ACQUIRE, "agent");
            asm volatile("s_waitcnt vmcnt(0)" ::: "memory");
        }
    }
    __syncthreads();
}

__device__ __forceinline__ float wsum(float v, int lane) {
#pragma unroll
    for (int o = 32; o >= 1; o >>= 1) v += __int_as_float(__builtin_amdgcn_ds_bpermute((lane ^ o) << 2, __float_as_int(v)));
    return v;
}
template <bool FINAL>
__device__ __forceinline__ void norm_row(int row, int lane, const float* src, float* h, const bf16_t* y2, bool add_y, bool write_h, const float* gain, bf16_t* abf) {
    const f32x4* s4 = (const f32x4*)(src + (size_t)row * D) + lane;
    f32x4 v[8]; float ss = 0.f;
#pragma unroll
    for (int j = 0; j < 8; ++j) v[j] = s4[64 * j];
    if (add_y) {
        const u32x2* ya = (const u32x2*)(y2 + (size_t)(2 * row) * D) + lane; const u32x2* yb = (const u32x2*)(y2 + (size_t)(2 * row + 1) * D) + lane;
#pragma unroll
        for (int j = 0; j < 8; ++j) { const u32x2 a = ya[64 * j], b = yb[64 * j];
            v[j][0] += __uint_as_float(a.x << 16) + __uint_as_float(b.x << 16); v[j][1] += __uint_as_float(a.x & 0xffff0000u) + __uint_as_float(b.x & 0xffff0000u);
            v[j][2] += __uint_as_float(a.y << 16) + __uint_as_float(b.y << 16); v[j][3] += __uint_as_float(a.y & 0xffff0000u) + __uint_as_float(b.y & 0xffff0000u); }
    }
#pragma unroll
    for (int j = 0; j < 8; ++j) ss += (v[j][0] * v[j][0] + v[j][1] * v[j][1]) + (v[j][2] * v[j][2] + v[j][3] * v[j][3]);
    const float rstd = 1.0f / sqrtf(wsum(ss, lane) * (1.0f / D) + EPS);
    const f32x4* g4 = (const f32x4*)gain + lane;
    if (FINAL) { f32x4* o4 = (f32x4*)(h + (size_t)row * D) + lane;
#pragma unroll
        for (int j = 0; j < 8; ++j) o4[64 * j] = v[j] * rstd * g4[64 * j];
    } else {
        if (write_h) { f32x4* o4 = (f32x4*)(h + (size_t)row * D) + lane;
#pragma unroll
            for (int j = 0; j < 8; ++j) o4[64 * j] = v[j]; }
        u32x2* a2 = (u32x2*)(abf + (size_t)row * D) + lane;
#pragma unroll
        for (int j = 0; j < 8; ++j) { const f32x4 o = v[j] * rstd * g4[64 * j]; u32x2 w; w.x = pk2(o[0], o[1]); w.y = pk2(o[2], o[3]); a2[64 * j] = w; }
    }
}
__device__ __forceinline__ void mla_prep_row(int row, int lane, const bf16_t* raw, const float* qn, const float* kvn, const float2* cs, bf16_t* cq, bf16_t* ckv, bf16_t* kr) {
    const bf16_t* r = raw + (size_t)row * 1280;
#pragma unroll
    for (int part = 0; part < 2; ++part) {
        const u32x4 v = *(const u32x4*)(r + part * 512 + 8 * lane); const unsigned w[4] = {v.x, v.y, v.z, v.w};
        float x[8]; float ss = 0.f;
#pragma unroll
        for (int j = 0; j < 4; ++j) { x[2 * j] = __uint_as_float(w[j] << 16); x[2 * j + 1] = __uint_as_float(w[j] & 0xffff0000u); ss += x[2 * j] * x[2 * j] + x[2 * j + 1] * x[2 * j + 1]; }
        const float rstd = 1.0f / sqrtf(wsum(ss, lane) * (1.0f / 512.0f) + EPS);
        const float* g = (part ? kvn : qn) + 8 * lane;
        u32x4 o; o.x = pk2(x[0] * rstd * g[0], x[1] * rstd * g[1]); o.y = pk2(x[2] * rstd * g[2], x[3] * rstd * g[3]); o.z = pk2(x[4] * rstd * g[4], x[5] * rstd * g[5]); o.w = pk2(x[6] * rstd * g[6], x[7] * rstd * g[7]);
        *(u32x4*)((part ? ckv : cq) + (size_t)row * 512 + 8 * lane) = o;
    }
    if (lane < 32) {
        const float x1 = bf2f(r[1024 + lane]), x2 = bf2f(r[1024 + 32 + lane]); const float2 c = cs[(size_t)row * 32 + lane];
        *(unsigned*)(kr + (size_t)row * 64 + 2 * lane) = pk2(x1 * c.x - x2 * c.y, x2 * c.x + x1 * c.y);
    }
}
__device__ __forceinline__ void fox_qknorm_row(int row, int lane, bf16_t* Q, bf16_t* K, const float* gq, const float* gk) {
#pragma unroll
    for (int part = 0; part < 2; ++part) {
        bf16_t* p = (part ? K : Q) + (size_t)row * 2048 + 32 * lane; const float* g = (part ? gk : gq) + 32 * (lane & 3);
        u32x4 v[4]; float ss = 0.f;
#pragma unroll
        for (int j = 0; j < 4; ++j) { v[j] = *(const u32x4*)(p + 8 * j); const unsigned w[4] = {v[j].x, v[j].y, v[j].z, v[j].w};
#pragma unroll
            for (int e = 0; e < 4; ++e) { const float a = __uint_as_float(w[e] << 16), b = __uint_as_float(w[e] & 0xffff0000u); ss += a * a + b * b; } }
        ss += __int_as_float(__builtin_amdgcn_ds_bpermute((lane ^ 1) << 2, __float_as_int(ss))); ss += __int_as_float(__builtin_amdgcn_ds_bpermute((lane ^ 2) << 2, __float_as_int(ss)));
        const float sc = (1.0f / sqrtf(ss * (1.0f / 128.0f) + EPS)) * (part ? 1.0f : QS_FOX);
#pragma unroll
        for (int j = 0; j < 4; ++j) { const unsigned w[4] = {v[j].x, v[j].y, v[j].z, v[j].w}; unsigned o[4];
#pragma unroll
            for (int e = 0; e < 4; ++e) { const float a = __uint_as_float(w[e] << 16), b = __uint_as_float(w[e] & 0xffff0000u); o[e] = pk2(a * sc * g[8 * j + 2 * e], b * sc * g[8 * j + 2 * e + 1]); }
            u32x4 ov; ov.x = o[0]; ov.y = o[1]; ov.z = o[2]; ov.w = o[3]; *(u32x4*)(p + 8 * j) = ov; }
    }
}
__device__ __forceinline__ void fox_scan_bh(int bh, int lane, const float* logf, float* nck) {
    const int b = bh / NH, hh = bh % NH;
    const float* src = logf + ((size_t)b * S + 64 * lane) * 16 + hh;
    float tot = 0.f;
#pragma unroll 8
    for (int i = 0; i < 64; ++i) tot += src[(size_t)i * 16];
    float inc = tot;
#pragma unroll
    for (int o = 1; o < 64; o <<= 1) { const float t = __int_as_float(__builtin_amdgcn_ds_bpermute((lane - o) << 2, __float_as_int(inc))); if (lane >= o) inc += t; }
    float run = inc - tot;
    float* dst = nck + (size_t)bh * S + 64 * lane;
#pragma unroll 8
    for (int i = 0; i < 64; ++i) { run += src[(size_t)i * 16]; dst[i] = -run * LOG2E; }
}
__device__ __forceinline__ void router_iter(LAS unsigned char* sc, int tid, int r0, const float* h, const float* gain, const float* wt  , const float* bg, const float* br,
                                            bf16_t* abf, unsigned* cnt, int* rowlist, float* roww) {
    const int wid = __builtin_amdgcn_readfirstlane(tid >> 6), lane = tid & 63, ri = lane & 15, kq = lane >> 4;
    LAS float* SSQ = (LAS float*)sc; LAS float* PART = (LAS float*)(sc + 512); LAS float* LOG = (LAS float*)(sc + 512 + 24576);
    const int kb = 256 * wid + 4 * kq;
    const float* hp = h + (size_t)(r0 + ri) * D + kb;
    f32x4 x[16]; float ss = 0.f;
#pragma unroll
    for (int j = 0; j < 16; ++j) x[j] = *(const f32x4*)(hp + 16 * j);
#pragma unroll
    for (int j = 0; j < 16; ++j) { ss += (x[j][0] * x[j][0] + x[j][1] * x[j][1]) + (x[j][2] * x[j][2] + x[j][3] * x[j][3]); x[j] = x[j] * *(const f32x4*)(gain + kb + 16 * j); }
    ss += __int_as_float(__builtin_amdgcn_ds_bpermute((lane ^ 16) << 2, __float_as_int(ss))); ss += __int_as_float(__builtin_amdgcn_ds_bpermute((lane ^ 32) << 2, __float_as_int(ss)));
    if (kq == 0) SSQ[wid * 16 + ri] = ss;
    f32x4 acc[3] = {{0.f, 0.f, 0.f, 0.f}, {0.f, 0.f, 0.f, 0.f}, {0.f, 0.f, 0.f, 0.f}};
#pragma unroll
    for (int j = 0; j < 16; ++j) {
        f32x4 wv[3];
#pragma unroll
        for (int nb = 0; nb < 3; ++nb) wv[nb] = *(const f32x4*)(wt + (size_t)(16 * nb + ri) * D + kb + 16 * j);
#pragma unroll
        for (int e = 0; e < 4; ++e)
#pragma unroll
            for (int nb = 0; nb < 3; ++nb) acc[nb] = __builtin_amdgcn_mfma_f32_16x16x4f32(x[j][e], wv[nb][e], acc[nb], 0, 0, 0);
    }
#pragma unroll
    for (int nb = 0; nb < 3; ++nb)
#pragma unroll
        for (int reg = 0; reg < 4; ++reg) PART[(wid * 48 + 16 * nb + ri) * 16 + 4 * kq + reg] = acc[nb][reg];
    __syncthreads();
    float sq = 0.f;
#pragma unroll
    for (int w = 0; w < 8; ++w) sq += SSQ[w * 16 + ri];
    const float rstd = 1.0f / sqrtf(sq * (1.0f / D) + EPS);
    bf16_t* ap = abf + (size_t)(r0 + ri) * D + kb;
#pragma unroll
    for (int j = 0; j < 16; ++j) { u32x2 w2; w2.x = pk2(x[j][0] * rstd, x[j][1] * rstd); w2.y = pk2(x[j][2] * rstd, x[j][3] * rstd); *(u32x2*)(ap + 16 * j) = w2; }
    for (int i = tid; i < 768; i += 512) { const int c = i >> 4, r = i & 15; float t = 0.f;
#pragma unroll
        for (int w = 0; w < 8; ++w) t += PART[(w * 48 + c) * 16 + r];
        LOG[r * 48 + c] = t; }
    __syncthreads();
    if (tid < 16) {
        const int r = tid; float sq2 = 0.f;
#pragma unroll
        for (int w = 0; w < 8; ++w) sq2 += SSQ[w * 16 + r];
        const float rs = 1.0f / sqrtf(sq2 * (1.0f / D) + EPS);
        float gmax = -3.0e38f; int gs = 0; float gl[8];
#pragma unroll
        for (int c = 0; c < 8; ++c) { gl[c] = LOG[r * 48 + c] * rs + bg[c]; if (gl[c] > gmax) { gmax = gl[c]; gs = c; } }
        float gsum = 0.f;
#pragma unroll
        for (int c = 0; c < 8; ++c) gsum += expf(gl[c] - gmax);
        const float gw = 1.0f / gsum;
        float el[4];
#pragma unroll
        for (int j = 0; j < 4; ++j) el[j] = LOG[r * 48 + 8 + 4 * gs + j] * rs + br[4 * gs + j];
        int j1 = 0; float m1 = el[0];
#pragma unroll
        for (int j = 1; j < 4; ++j) if (el[j] > m1) { m1 = el[j]; j1 = j; }
        int j2 = -1; float m2 = -3.0e38f;
#pragma unroll
        for (int j = 0; j < 4; ++j) if (j != j1 && el[j] > m2) { m2 = el[j]; j2 = j; }
        const float e2 = expf(m2 - m1), w1 = gw / (1.0f + e2), w2 = gw * e2 / (1.0f + e2);
        const int row = r0 + r;
        { const int e = gs * 4 + j1; const unsigned rk = atomicAdd(cnt + e, 1u); rowlist[e * ECAP + rk] = row * 2; roww[e * ECAP + rk] = w1; }
        { const int e = gs * 4 + j2; const unsigned rk = atomicAdd(cnt + e, 1u); rowlist[e * ECAP + rk] = row * 2 + 1; roww[e * ECAP + rk] = w2; }
    }
    __syncthreads();
}

namespace att {
constexpr int NW = 8, QBLK = 32, KVBLK = 64, QB = 256, PITCH = 2048;
constexpr int SHM_V = 16384, SHM_K = 16384, SHM_KR = 8192, SHM_NCK = 16384;
constexpr int OFF_K = 2 * SHM_V, OFF_WS = OFF_K + 2 * SHM_K, OFF_X = OFF_WS + 2048;
constexpr int OFF_QR = OFF_X + 2 * SHM_KR;
constexpr int LDS_NEED = OFF_QR + 8 * 4096;
static_assert(LDS_NEED <= RING_BYTES, "attention LDS");
constexpr float THR2 = 11.5f;
typedef float f32x16 __attribute__((ext_vector_type(16)));
typedef short s16x4 __attribute__((ext_vector_type(4)));
typedef LAS char* lptr;

#define KSWZ(row, colB) ((row) * 256 + ((colB) ^ (((row) & 7) << 4)))
#define KRSWZ(row, colB) ((row) * 128 + ((colB) ^ (((row) & 7) << 4)))
#define SBAR() __builtin_amdgcn_sched_barrier(0)
__device__ __forceinline__ int v_st(int k, int c) { const int kk = (k & ~0xC) | ((k & 4) << 1) | ((k & 8) >> 1); return ((kk >> 3) * 4 + (c >> 5)) * 512 + ((kk & 7) * 32 + (c & 31)) * 2; }
__device__ __forceinline__ int v_rd_base(int lane) { return ((lane & 3) << 3) | (((lane >> 2) & 3) << 6) | (((lane >> 4) & 1) << 5) | (((lane >> 5) & 1) << 8); }
constexpr int v_rd_off(int d0, int ks, int half) { return d0 * 512 + ks * 4096 + half * 2048; }
__device__ __forceinline__ int crow(int r, int hi) { return (r & 3) + 8 * (r >> 2) + 4 * hi; }
__device__ __forceinline__ unsigned cvtpk(float lo, float hi) { unsigned r; asm volatile("v_cvt_pk_bf16_f32 %0, %1, %2" : "=v"(r) : "v"(lo), "v"(hi)); return r; }
__device__ __forceinline__ void glds16(const void* gsrc, unsigned lds_dst) { unsigned keep;
    asm volatile("s_mov_b32 %0, m0\n\ts_mov_b32 m0, %2\n\ts_nop 0\n\tglobal_load_lds_dwordx4 %1, off\n\ts_mov_b32 m0, %0" : "=&s"(keep) : "v"(gsrc), "s"(lds_dst) : "memory"); }
__device__ __forceinline__ void mask_tile(f32x16& p0, f32x16& p1, int dq) {
    const float NEG = -__builtin_inff();
#pragma unroll
    for (int r = 0; r < 16; ++r) { const int c = (r & 3) + 8 * (r >> 2); if (dq - c < 0) p0[r] = NEG; if (dq - c - 32 < 0) p1[r] = NEG; }
}
__device__ __forceinline__ void partialSM(f32x16& p0, f32x16& p1, float& m_reg, float& mn, float& alpha) {
    float pmax = p0[0];
#pragma unroll
    for (int r = 1; r < 16; ++r) pmax = fmaxf(pmax, p0[r]);
#pragma unroll
    for (int r = 0; r < 16; ++r) pmax = fmaxf(pmax, p1[r]);
    { auto rr = __builtin_amdgcn_permlane32_swap(__float_as_uint(pmax), __float_as_uint(pmax), false, false); pmax = fmaxf(__uint_as_float(rr[0]), __uint_as_float(rr[1])); }
    if (__builtin_expect(__all((pmax - m_reg) <= THR2), 1)) { mn = m_reg; alpha = 1.f; }
    else { mn = fmaxf(m_reg, pmax); alpha = __builtin_amdgcn_exp2f(m_reg - mn); m_reg = mn; }
#pragma unroll
    for (int r = 0; r < 16; ++r) p0[r] = p0[r] - mn;
#pragma unroll
    for (int r = 0; r < 16; ++r) p1[r] = p1[r] - mn;
#pragma unroll
    for (int r = 0; r < 16; ++r) p0[r] = __builtin_amdgcn_exp2f(p0[r]);
}
__device__ __forceinline__ void finishSM(f32x16& p0, f32x16& p1, float alpha, float& l_reg, bf16x8& pa0, bf16x8& pa1, bf16x8& pa2, bf16x8& pa3) {
#pragma unroll
    for (int r = 0; r < 16; ++r) p1[r] = __builtin_amdgcn_exp2f(p1[r]);
    float ps = 0;
#pragma unroll
    for (int r = 0; r < 16; ++r) ps += p0[r];
#pragma unroll
    for (int r = 0; r < 16; ++r) ps += p1[r];
    { auto rr = __builtin_amdgcn_permlane32_swap(__float_as_uint(ps), __float_as_uint(ps), false, false); ps = __uint_as_float(rr[0]) + __uint_as_float(rr[1]); }
    l_reg = l_reg * alpha + ps;
#define PK4(P, B_, OUT) do { unsigned a0 = cvtpk(P[B_+0], P[B_+1]), a1 = cvtpk(P[B_+2], P[B_+3]); unsigned b0 = cvtpk(P[B_+4], P[B_+5]), b1 = cvtpk(P[B_+6], P[B_+7]); \
        auto r0 = __builtin_amdgcn_permlane32_swap(a0, b0, false, false); auto r1 = __builtin_amdgcn_permlane32_swap(a1, b1, false, false); \
        u32x4 w = {r0[0], r1[0], r0[1], r1[1]}; OUT = *reinterpret_cast<bf16x8*>(&w); } while (0)
    PK4(p0, 0, pa0); PK4(p0, 8, pa1); PK4(p1, 0, pa2); PK4(p1, 8, pa3);
#undef PK4
}
template <int KB, int MODE>
__device__ __forceinline__ void qkt(f32x16& p0, f32x16& p1, lptr K_lds, lptr X_lds, lptr qrw, const LAS float* nckt, int r32, int hi, const bf16x8* qr) {
    if (MODE == 1) {
#pragma unroll
        for (int g = 0; g < 4; ++g) { const f32x4 a = *(const LAS f32x4*)(nckt + 8 * g + 4 * hi), b = *(const LAS f32x4*)(nckt + 32 + 8 * g + 4 * hi);
#pragma unroll
            for (int e = 0; e < 4; ++e) { p0[4 * g + e] = a[e]; p1[4 * g + e] = b[e]; } }
    } else { p0 = f32x16{}; p1 = f32x16{}; }
    lptr kb[4];
#pragma unroll
    for (int dd = 0; dd < 4; ++dd) kb[dd] = K_lds + KB * SHM_K + KSWZ(r32, (dd * 16 + hi * 8) * 2);
#pragma unroll
    for (int d0 = 0; d0 < 8; ++d0) { lptr a = kb[d0 & 3] + (d0 >> 2) * 128;
        bf16x8 b0 = *(const LAS bf16x8*)(a);
        bf16x8 b1 = *(const LAS bf16x8*)(a + 32 * 256);
        p0 = __builtin_amdgcn_mfma_f32_32x32x16_bf16(b0, qr[d0], p0, 0, 0, 0);
        p1 = __builtin_amdgcn_mfma_f32_32x32x16_bf16(b1, qr[d0], p1, 0, 0, 0); }
    if (MODE == 0) {
#pragma unroll
        for (int d0 = 0; d0 < 4; ++d0) { lptr a = X_lds + KB * SHM_KR + d0 * 2048 + r32 * 32 + hi * 16;
            bf16x8 b0 = *(const LAS bf16x8*)(a);
            bf16x8 b1 = *(const LAS bf16x8*)(a + 1024);
            bf16x8 q = *(const LAS bf16x8*)(qrw + d0 * 1024);
            p0 = __builtin_amdgcn_mfma_f32_32x32x16_bf16(b0, q, p0, 0, 0, 0);
            p1 = __builtin_amdgcn_mfma_f32_32x32x16_bf16(b1, q, p1, 0, 0, 0); }
    }
}
template <int VB>
__device__ __forceinline__ void pv_tile(f32x16* o, int vb0, bf16x8 pa0, bf16x8 pa1, bf16x8 pa2, bf16x8 pa3) {
#define TRRD(dst, off) asm volatile("ds_read_b64_tr_b16 %0, %1 offset:%2" : "=&v"(dst) : "v"(vb0), "i"(off) : "memory")
#define PV_D0(d0) do { s16x4 l0, l1, l2, l3, h0, h1, h2, h3; constexpr int b_ = VB * SHM_V + v_rd_off(d0, 0, 0); \
        TRRD(l0, b_); TRRD(h0, b_ + 2048); TRRD(l1, b_ + 4096); TRRD(h1, b_ + 6144); TRRD(l2, b_ + 8192); TRRD(h2, b_ + 10240); TRRD(l3, b_ + 12288); TRRD(h3, b_ + 14336); \
        asm volatile("s_waitcnt lgkmcnt(0)" ::: "memory"); SBAR(); \
        o[d0] = __builtin_amdgcn_mfma_f32_32x32x16_bf16(pa0, (bf16x8){l0[0], l0[1], l0[2], l0[3], h0[0], h0[1], h0[2], h0[3]}, o[d0], 0, 0, 0); \
        o[d0] = __builtin_amdgcn_mfma_f32_32x32x16_bf16(pa1, (bf16x8){l1[0], l1[1], l1[2], l1[3], h1[0], h1[1], h1[2], h1[3]}, o[d0], 0, 0, 0); \
        o[d0] = __builtin_amdgcn_mfma_f32_32x32x16_bf16(pa2, (bf16x8){l2[0], l2[1], l2[2], l2[3], h2[0], h2[1], h2[2], h2[3]}, o[d0], 0, 0, 0); \
        o[d0] = __builtin_amdgcn_mfma_f32_32x32x16_bf16(pa3, (bf16x8){l3[0], l3[1], l3[2], l3[3], h3[0], h3[1], h3[2], h3[3]}, o[d0], 0, 0, 0); } while (0)
    PV_D0(0); PV_D0(1); PV_D0(2); PV_D0(3);
#undef PV_D0
#undef TRRD
}

struct Ref { const bf16_t* Q; const bf16_t* K; const bf16_t* V; bf16_t* O; const bf16_t* Qr; const bf16_t* Kr; const float* nck; const bf16_t* G; int P0; };
struct Seam { bf16x8 qr[8]; bf16x8 st_v0, st_v1, st_k0, st_k1; int par; };

#define ROWP(p, k0, rr) ((p) + (size_t)((k0) + (rr)) * PITCH + sc)
#define VMW() asm volatile("s_waitcnt vmcnt(0)" ::: "memory")
#define VMWN(n) asm volatile("s_waitcnt vmcnt(%0)" :: "i"(n) : "memory")
#define LD8(p) (*(const bf16x8*)(p))
#define SLOAD_H(R_, k0, bf) do { S.st_v0 = LD8(ROWP((R_).V, k0, sr)); S.st_v1 = LD8(ROWP((R_).V, k0, 32 + sr)); S.st_k0 = LD8(ROWP((R_).K, k0, sr)); S.st_k1 = LD8(ROWP((R_).K, k0, 32 + sr)); \
        if (MODE == 0) glds16((R_).Kr + (size_t)(k0) * 64 + krg, (unsigned)__builtin_amdgcn_readfirstlane(xbase + (bf) * SHM_KR + wid * 1024)); } while (0)
#define SWRITE_HK(bf) do { *(LAS bf16x8*)(K_lds + (bf) * SHM_K + kws) = S.st_k0; *(LAS bf16x8*)(K_lds + (bf) * SHM_K + kws + 32 * 256) = S.st_k1; } while (0)
#define SWRITE_HV(bf) do { *(LAS bf16x8*)(V_lds + (bf) * SHM_V + vst0) = S.st_v0; *(LAS bf16x8*)(V_lds + (bf) * SHM_V + vst1) = S.st_v1; } while (0)
#define SWRITE_H(bf) do { SWRITE_HV(bf); SWRITE_HK(bf); } while (0)

template <int MODE>
__device__ __forceinline__ void side_load(const Ref& R, lptr lds, int tid, int par) {
    const int wid = __builtin_amdgcn_readfirstlane(tid >> 6), lane = tid & 63, r32 = lane & 31, hi = lane >> 5;
    if (MODE == 0) { const unsigned dst = (unsigned)(uintptr_t)(lds + OFF_QR + wid * 4096);
#pragma unroll
        for (int d0 = 0; d0 < 4; ++d0) glds16(R.Qr + (size_t)(wid * QBLK + r32) * 1024 + d0 * 16 + hi * 8, (unsigned)__builtin_amdgcn_readfirstlane(dst + d0 * 1024));
    } else { const int n4 = (R.P0 + QB) >> 2; f32x4 t0 = {0.f, 0.f, 0.f, 0.f}, t1 = t0;
        if (tid < n4) t0 = *(const f32x4*)(R.nck + 4 * tid);
        if (tid + 512 < n4) t1 = *(const f32x4*)(R.nck + 4 * (tid + 512));
        LAS f32x4* dst = (LAS f32x4*)(lds + OFF_X + par * SHM_NCK);
        dst[tid] = t0; dst[tid + 512] = t1; }
}
template <int MODE>
__device__ __forceinline__ void attn_prime(const Ref& cur, lptr lds, Seam& S, const int wv) {
    const int tid = wv * 64 + lane_id_v();
    const int wid = __builtin_amdgcn_readfirstlane(tid >> 6), lane = tid & 63, r32 = lane & 31, hi = lane >> 5;
    const int sr = tid >> 4, sc = (tid & 15) * 8, kws = KSWZ(sr, sc * 2);
    const int krg = (32 * (wid & 1) + (lane >> 1)) * 64 + (wid >> 1) * 16 + (lane & 1) * 8; const unsigned xbase = (unsigned)(uintptr_t)(lds + OFF_X);
    lptr K_lds = lds + OFF_K;
    S.par = 0;
#pragma unroll
    for (int d0 = 0; d0 < 8; ++d0) S.qr[d0] = LD8(cur.Q + (size_t)(wid * QBLK + r32) * PITCH + d0 * 16 + hi * 8);
    SLOAD_H(cur, 0, 0);
    side_load<MODE>(cur, lds, tid, 0);
    VMW(); SWRITE_HK(0);
    __syncthreads();
}
template <int MODE>
__device__ __forceinline__ void attn_block(const Ref& cur, const Ref& nxt, lptr lds, Seam& S, const int wv) {
    const int tid = wv * 64 + lane_id_v();
    const int wid = __builtin_amdgcn_readfirstlane(tid >> 6), lane = tid & 63, r32 = lane & 31, hi = lane >> 5;
    const int NT = (cur.P0 + QB - 1) / KVBLK + 1;
    const int qlo = cur.P0 + wid * QBLK;
    const int qle = MODE == 0 ? (qlo | 63) : qlo;
    const int qm = (MODE == 0 ? (qlo | 63) : qlo + r32) - 4 * hi;
    lptr V_lds = lds, K_lds = lds + OFF_K, X_lds = lds + OFF_X, qrw = lds + OFF_QR + wid * 4096 + lane * 16;
    LAS float* ws = (LAS float*)(lds + OFF_WS) + wid * 64; LAS float* li_l = ws; LAS float* al_l = ws + 32;
    const LAS float* nckb = (const LAS float*)(lds + OFF_X + S.par * SHM_NCK);
    float m_reg = -1e30f, l_reg = 0; f32x16 o[4] = {};
    const int sr = tid >> 4, sc = (tid & 15) * 8, vst0 = v_st(sr, sc), vst1 = v_st(32 + sr, sc), kws = KSWZ(sr, sc * 2);
    const int krg = (32 * (wid & 1) + (lane >> 1)) * 64 + (wid >> 1) * 16 + (lane & 1) * 8; const unsigned xbase = (unsigned)(uintptr_t)(lds + OFF_X);
    const int vb0 = (int)(uintptr_t)V_lds + v_rd_base(lane);
#define RESC(a) do { if (__any((a) < 1.f)) { if (hi == 0) al_l[r32] = (a); asm volatile("s_waitcnt lgkmcnt(0)" ::: "memory"); \
                     for (int d_ = 0; d_ < 4; ++d_) for (int r = 0; r < 16; ++r) o[d_][r] *= al_l[crow(r, hi)]; } } while (0)
#define KBASE(t) ((t) * KVBLK)
#define MASKT(P0_, P1_, t) do { const int kb_ = KBASE(t); if (kb_ + KVBLK - 1 > qle) mask_tile(P0_, P1_, qm - kb_); } while (0)
#define QKT(KB, PX0, PX1, t) qkt<KB, MODE>(PX0, PX1, K_lds, X_lds, qrw, nckb + KBASE(t), r32, hi, S.qr)
    f32x16 pA0, pA1, pB0, pB1; float mnA, mnB, alA, alB; bf16x8 pa0, pa1, pa2, pa3;
    SWRITE_HV(0); SBAR();
    SLOAD_H(cur, KBASE(1), 1);
    SBAR(); QKT(0, pA0, pA1, 0);
    MASKT(pA0, pA1, 0); partialSM(pA0, pA1, m_reg, mnA, alA);
    VMW(); SWRITE_H(1);
    __syncthreads();
#define HALF_STEP(PX0, PX1, mnX, alX, PY0, PY1, alY, t, KB, VB, SB) do { \
        SBAR(); QKT(KB, PX0, PX1, t); \
        finishSM(PY0, PY1, alY, l_reg, pa0, pa1, pa2, pa3); SBAR(); \
        if ((t) + 1 < NT) { SLOAD_H(cur, KBASE((t) + 1), SB); SBAR(); } \
        pv_tile<VB>(o, vb0, pa0, pa1, pa2, pa3); MASKT(PX0, PX1, (t)); partialSM(PX0, PX1, m_reg, mnX, alX); \
        __syncthreads(); \
        if ((t) + 1 < NT) { VMW(); SWRITE_H(SB); } \
        RESC(alX); __syncthreads(); } while (0)
    for (int t = 1; t + 1 < NT; t += 2) {
        HALF_STEP(pB0, pB1, mnB, alB, pA0, pA1, alA, t, 1, 0, 0);
        HALF_STEP(pA0, pA1, mnA, alA, pB0, pB1, alB, t + 1, 0, 1, 1);
    }
    const bool even = (NT & 1) == 0;
    if (even) { SBAR(); QKT(1, pB0, pB1, NT - 1); SBAR(); }
    SLOAD_H(nxt, 0, 0); SBAR();
    if (MODE == 0) { side_load<MODE>(nxt, lds, tid, 0); SBAR(); }
#pragma unroll
    for (int d0 = 0; d0 < 8; ++d0) S.qr[d0] = LD8(nxt.Q + (size_t)(wid * QBLK + r32) * PITCH + d0 * 16 + hi * 8);
    SBAR();
    finishSM(pA0, pA1, alA, l_reg, pa0, pa1, pa2, pa3); SBAR();
    pv_tile<0>(o, vb0, pa0, pa1, pa2, pa3);
    if (even) { MASKT(pB0, pB1, NT - 1); partialSM(pB0, pB1, m_reg, mnB, alB); __syncthreads(); RESC(alB);
        finishSM(pB0, pB1, alB, l_reg, pa0, pa1, pa2, pa3); SBAR(); pv_tile<1>(o, vb0, pa0, pa1, pa2, pa3); }
    SBAR(); VMWN(8); SWRITE_HK(0); SBAR();
    if (hi == 0) li_l[r32] = l_reg; asm volatile("s_waitcnt lgkmcnt(0)" ::: "memory");
    float rli[16];
#pragma unroll
    for (int r = 0; r < 16; ++r) rli[r] = __builtin_amdgcn_rcpf(li_l[crow(r, hi)]);
    bf16_t* Ow = cur.O + (size_t)(wid * QBLK) * PITCH; const bf16_t* Gw = cur.G + (size_t)(wid * QBLK) * PITCH;
#pragma unroll
    for (int r = 0; r < 16; ++r) { const int orow = crow(r, hi);
#pragma unroll
        for (int d0 = 0; d0 < 4; ++d0) { float v = o[d0][r] * rli[r];
            if (MODE == 1) v *= bf2f(Gw[(size_t)orow * PITCH + d0 * 32 + r32]);
            const float vn = __uint_as_float(__builtin_amdgcn_mov_dpp(__float_as_uint(v), 0xB1, 0xf, 0xf, true));
            if ((r32 & 1) == 0) *(unsigned*)(Ow + (size_t)orow * PITCH + d0 * 32 + r32) = cvtpk(v, vn); } }
    if (MODE == 1) side_load<MODE>(nxt, lds, tid, S.par ^ 1);
    S.par ^= 1;
    __syncthreads();
#undef RESC
#undef KBASE
#undef MASKT
#undef QKT
#undef HALF_STEP
}
#undef ROWP
#undef VMW
#undef VMWN
#undef LD8
#undef SLOAD_H
#undef SWRITE_HK
#undef SWRITE_HV
#undef SWRITE_H

struct Bufs { const bf16_t* Q; const bf16_t* K; const bf16_t* V; bf16_t* O; const bf16_t* Qr; const bf16_t* Kr; const float* nck; const bf16_t* G; };
__device__ __forceinline__ Ref make_ref(const Bufs& B, int item, int pass) {
    const int bh = item >> 3, x = item & 7, qb = pass ? 15 - x : x, b = bh >> 4, hh = bh & 15;
    const size_t t0 = (size_t)b * S, tq = t0 + (size_t)qb * QB;
    Ref r; r.Q = B.Q + tq * PITCH + hh * 128; r.O = B.O + tq * PITCH + hh * 128; r.G = B.G + tq * PITCH + hh * 128;
    r.K = B.K + t0 * PITCH + hh * 128; r.V = B.V + t0 * PITCH + hh * 128; r.Qr = B.Qr + tq * 1024 + hh * 64; r.Kr = B.Kr + t0 * 64; r.nck = B.nck + (size_t)bh * S; r.P0 = qb * QB;
    return r;
}
template <int MODE>
__device__ __forceinline__ void attn_phase(lptr lds, const Bufs& B, int vcu, int G, const int wv) {
    constexpr int total = NB * NH * 8;
    int L = vcu; if (L >= total) return;
    int pass = 0; Ref cur = make_ref(B, L, 0);
    Seam S;
    attn_prime<MODE>(cur, lds, S, wv);
    for (;;) {
        const bool more_pass = pass == 0, more_item = L + G < total, last = !more_pass && !more_item;
        int passn = pass + 1, Ln = L;
        if (!more_pass) { passn = 0; Ln = more_item ? L + G : L; }
        const Ref nxt = last ? cur : make_ref(B, Ln, passn);
        attn_block<MODE>(cur, nxt, lds, S, wv);
        if (last) break;
        cur = nxt; pass = passn; L = Ln;
    }
}
}

struct Args { const float* in[26]; float* out; unsigned char* ws; int L0, L1, ph_lo, ph_hi, use_bar, pad; };
enum { PH_PRO = 0, PH_NORM = 1, PH_MLA_A = 2, PH_MLA_PREP = 3, PH_MLA_QKV = 4, PH_MLA_ATT = 5, PH_MLA_WO = 6, PH_FOX_A = 7, PH_FOX_PREP = 8, PH_FOX_ATT = 9, PH_FOX_WO = 10,
       PH_ROUTER = 11, PH_MOE_GU = 12, PH_MOE_D = 13, PH_FINAL = 14, PH_END = 15 };

struct CvtJob { const float* src; int ld, K, ncols, perm, k0; bf16_t* dst; int drow0; };
__device__ __forceinline__ bool cvt_decode(const Args& A, int r, CvtJob& J) {
    unsigned char* ws = A.ws; J.ncols = 64; J.perm = 0; J.K = 2048;
    if (r < 512) { const int j = r >> 8, q = r & 255, kb = q >> 3, nb = q & 7; J.src = A.in[5] + (size_t)j * 2048 * 512 + nb * 64; J.ld = 512; J.dst = (bf16_t*)(ws + WS_W_MLA_A) + (size_t)j * 1280 * 2048; J.drow0 = nb * 64; J.k0 = kb * 64; return true; } r -= 512;
    if (r < 576) { const int j = r / 288, q = r % 288, kb = q / 9, nb = q % 9; J.src = A.in[8] + (size_t)j * 2048 * 576 + nb * 64; J.ld = 576; J.dst = (bf16_t*)(ws + WS_W_MLA_A) + (size_t)j * 1280 * 2048; J.drow0 = 512 + nb * 64; J.k0 = kb * 64; return true; } r -= 576;
    if (r < 768) { const int j = r / 384, q = r % 384, kb = q / 48, nb = q % 48, hh = nb / 3, part = nb % 3; J.src = A.in[7] + (size_t)j * 512 * 3072 + hh * 192 + part * 64; J.ld = 3072; J.K = 512;
        J.dst = (bf16_t*)(ws + WS_W_MLA_UQ) + (size_t)j * 3072 * 512; J.drow0 = part < 2 ? hh * 128 + part * 64 : 2048 + hh * 64; J.perm = part == 2; J.k0 = kb * 64; return true; } r -= 768;
    if (r < 1024) { const int j = r >> 9, q = r & 511, kb = q >> 6, nb = q & 63, hh = nb >> 2, which = (nb >> 1) & 1, half = nb & 1; J.src = A.in[10] + (size_t)j * 512 * 4096 + nb * 64; J.ld = 4096; J.K = 512;
        J.dst = (bf16_t*)(ws + WS_W_MLA_UKV) + (size_t)j * 4096 * 512; J.drow0 = which * 2048 + hh * 128 + half * 64; J.k0 = kb * 64; return true; } r -= 1024;
    if (r < 2048) { const int j = r >> 10, q = r & 1023, kb = q >> 5, nb = q & 31; J.src = A.in[11] + (size_t)j * 2048 * 2048 + nb * 64; J.ld = 2048; J.dst = (bf16_t*)(ws + WS_W_MLA_O) + (size_t)j * 2048 * 2048; J.drow0 = nb * 64; J.k0 = kb * 64; return true; } r -= 2048;
    if (r < 6144) { const int j = r / 3072, q = r % 3072, kb = q / 96, nb = q % 96; J.src = A.in[12] + (size_t)j * 2048 * 6144 + nb * 64; J.ld = 6144; J.dst = (bf16_t*)(ws + WS_W_FOX_A) + (size_t)j * 8448 * 2048; J.drow0 = nb * 64; J.k0 = kb * 64; return true; } r -= 6144;
    if (r < 2048) { const int j = r >> 10, q = r & 1023, kb = q >> 5, nb = q & 31; J.src = A.in[17] + (size_t)j * 2048 * 2048 + nb * 64; J.ld = 2048; J.dst = (bf16_t*)(ws + WS_W_FOX_A) + (size_t)j * 8448 * 2048; J.drow0 = 6144 + nb * 64; J.k0 = kb * 64; return true; } r -= 2048;
    if (r < 64) { const int j = r >> 5, kb = r & 31; J.src = A.in[15] + (size_t)j * 2048 * 16; J.ld = 16; J.ncols = 16; J.dst = (bf16_t*)(ws + WS_W_FOX_A) + (size_t)j * 8448 * 2048; J.drow0 = 8192; J.k0 = kb * 64; return true; } r -= 64;
    if (r < 2048) { const int j = r >> 10, q = r & 1023, kb = q >> 5, nb = q & 31; J.src = A.in[18] + (size_t)j * 2048 * 2048 + nb * 64; J.ld = 2048; J.dst = (bf16_t*)(ws + WS_W_FOX_O) + (size_t)j * 2048 * 2048; J.drow0 = nb * 64; J.k0 = kb * 64; return true; } r -= 2048;
    if (r < 65536) { const int up = r >> 15, rr = r & 32767, le = rr >> 8, q = rr & 255, kb = q >> 3, nb = q & 7; J.src = A.in[23 + up] + (size_t)le * 2048 * 512 + nb * 64; J.ld = 512;
        J.dst = (bf16_t*)(ws + WS_W_GU) + (size_t)le * 1024 * 2048; J.drow0 = 256 * (nb >> 1) + 128 * up + 64 * (nb & 1); J.k0 = kb * 64; return true; } r -= 65536;
    if (r < 32768) { const int le = r >> 8, q = r & 255, kb = q >> 5, nb = q & 31; J.src = A.in[25] + (size_t)le * 512 * 2048 + nb * 64; J.ld = 2048; J.K = 512; J.dst = (bf16_t*)(ws + WS_W_D) + (size_t)le * 2048 * 512; J.drow0 = nb * 64; J.k0 = kb * 64; return true; }
    return false;
}
constexpr int CVT_ITEMS = 512 + 576 + 768 + 1024 + 2048 + 6144 + 2048 + 64 + 2048 + 65536 + 32768;
__device__ __forceinline__ void cvt_item(const CvtJob& J, LAS float* scr, int lane) {
    const int kr = lane >> 4, c4 = (lane & 15) * 4;
    if (c4 < J.ncols) {
#pragma unroll 4
        for (int it = 0; it < 16; ++it) { const int k = it * 4 + kr; const f32x4 v = *(const f32x4*)(J.src + (size_t)(J.k0 + k) * J.ld + c4);
            LAS float* p = scr + k * 65 + c4; p[0] = v[0]; p[1] = v[1]; p[2] = v[2]; p[3] = v[3]; }
    }
    LDS_WAIT(); asm volatile("" ::: "memory");
    const int ck = lane & 7;
#pragma unroll
    for (int it = 0; it < 8; ++it) { const int n = (lane >> 3) + 8 * it;
        if (n < J.ncols) { const int sn = J.perm ? ((n >> 1) + 32 * (n & 1)) : n; const LAS float* s = scr + (8 * ck) * 65 + sn;
            u32x4 o; o.x = pk2(s[0], s[65]); o.y = pk2(s[2 * 65], s[3 * 65]); o.z = pk2(s[4 * 65], s[5 * 65]); o.w = pk2(s[6 * 65], s[7 * 65]);
            *(u32x4*)(J.dst + (size_t)(J.drow0 + n) * J.K + J.k0 + 8 * ck) = o; } }
    LDS_WAIT(); asm volatile("" ::: "memory");
}

__device__ __forceinline__ size_t opq(size_t v) { asm volatile("" : "+s"(v)); return v; }
__device__ __forceinline__ int opqi(int v) { asm volatile("" : "+s"(v)); return v; }
__global__ void __launch_bounds__(512, 2) mega(Args args) {
    extern __shared__ __attribute__((aligned(16))) unsigned char lds_raw[];
    LAS unsigned char* lds = (LAS unsigned char*)lds_raw;
    const int wave = __builtin_amdgcn_readfirstlane((int)threadIdx.x >> 6);
    const int G0 = gridDim.x; const int bx0 = blockIdx.x; const int vcu0 = (G0 % 8 == 0) ? (bx0 % 8) * (G0 / 8) + bx0 / 8 : bx0;
    unsigned char* ws = args.ws;
    unsigned* ctl = (unsigned*)(ws + WS_CTL);
    for (int u = wave * 64 + lane_id_v(); u < LDS_CTL_BYTES / 4; u += 512) ((LAS unsigned*)lds)[u] = 0u;
    __syncthreads();
    XcdBarrier bar; bar.bar = ctl + CW_BAR; bar.x = 0; bar.st = (volatile LAS unsigned*)lds;
    if (args.use_bar) bar = xcd_barrier_post(ctl + CW_BAR, (volatile LAS unsigned*)lds, wave);
#define GRID_BAR() do { if (args.use_bar) xcd_barrier(bar, wave); } while (0)
#define IN(k) (lo <= (k) && (k) < hi)
    float* h = args.out;
    bf16_t* abf = (bf16_t*)(ws + opq(WS_ABF)); bf16_t* y2 = (bf16_t*)(ws + opq(WS_Y2));
    const float* cs = (const float*)(ws + opq(WS_ROPE));

    { const int lo = args.ph_lo, hi = args.ph_hi, G = G0, vcu = vcu0, gw = vcu * 8 + wave, NGW = G * 8;
    if (IN(PH_PRO) && args.L0 == 0) {
        const int lane = lane_id_v(), tid = wave * 64 + lane;
        LAS float* scr = (LAS float*)(lds + RING_OFF) + wave * (64 * 65);
        for (int it = gw; it < CVT_ITEMS; it += NGW) { CvtJob J; if (cvt_decode(args, it, J)) cvt_item(J, scr, lane); }
        for (int it = gw; it < 2 * 192 + 2 * 240; it += NGW) { bf16_t* rowp;
            if (it < 384) { const int j = it / 192, rr = it % 192; rowp = (bf16_t*)(ws + opq(WS_W_MLA_A)) + ((size_t)j * 1280 + 1088 + rr) * 2048; }
            else { const int q = it - 384, j = q / 240, rr = q % 240; rowp = (bf16_t*)(ws + opq(WS_W_FOX_A)) + ((size_t)j * 8448 + 8208 + rr) * 2048; }
#pragma unroll
            for (int c = 0; c < 4; ++c) ((u32x4*)rowp)[lane + 64 * c] = (u32x4){0u, 0u, 0u, 0u}; }
        { const int* pos = (const int*)args.in[opqi(1)]; float2* cst = (float2*)(ws + opq(WS_ROPE));
          for (int i = (vcu * 512 + tid); i < T * 32; i += G * 512) { const int t = i >> 5, f = i & 31; const float inv = powf(10000.0f, -(float)(2 * f) / 64.0f); const float ang = (float)pos[t] * inv;
              cst[i] = make_float2((float)cos((double)ang), (float)sin((double)ang)); } }
        { float* wrt = (float*)(ws + opq(WS_WRT));
          for (int i = (vcu * 512 + tid); i < 4 * 48 * 2048; i += G * 512) { const int k = i & 2047, c = (i >> 11) % 48, l = i / (48 * 2048);
              wrt[i] = c < 8 ? args.in[opqi(19)][((size_t)l * 2048 + k) * 8 + c] : (c < 40 ? args.in[opqi(21)][((size_t)l * 2048 + k) * 32 + (c - 8)] : 0.f); } }
        GRID_BAR();
    } }

    for (int L = args.L0; L < args.L1; ++L) {
        const int j = L >> 1; const bool mla = (L & 1) == 0;
        const int lo = opqi(args.ph_lo), hi = opqi(args.ph_hi), G = opqi(G0), bx = opqi(bx0), vcu = opqi(vcu0), gw = vcu * 8 + wave, NGW = G * 8;
        if (IN(PH_NORM)) {
            const int tidx = wave * 64 + lane_id_v(); const int rlane = tidx & 63;
            for (int row = gw; row < T; row += NGW) norm_row<false>(row, rlane, L == 0 ? args.in[opqi(0)] : h, h, y2, L != 0, true, args.in[opqi(2)] + (size_t)L * D, abf);
            GRID_BAR();
        }
        if (IN(PH_MLA_A) && mla) {
            pg8::Gemm g{abf, (const bf16_t*)(ws + opq(WS_W_MLA_A)) + (size_t)j * 1280 * 2048, 2048, 0}; pg8::StaticOrder S; S.init(T, 1280, G, bx);
            pg8::EpiBf16S E{(bf16_t*)(ws + opq(WS_RAW)), 1280, 0, 0, 1.0f};
            pg8::gemm_phase<pg8::EpiBf16S, pg8::StaticOrder, false>(lds + RING_OFF, g, S, E, wave);
            GRID_BAR();
        }
        if (IN(PH_MLA_PREP) && mla) {
            const int tidx = wave * 64 + lane_id_v(); const int rlane = tidx & 63;
            for (int row = gw; row < T; row += NGW) mla_prep_row(row, rlane, (const bf16_t*)(ws + opq(WS_RAW)), args.in[opqi(6)] + j * 512, args.in[opqi(9)] + j * 512, (const float2*)cs, (bf16_t*)(ws + opq(WS_CQ)), (bf16_t*)(ws + opq(WS_CKV)), (bf16_t*)(ws + opq(WS_KR)));
            GRID_BAR();
        }
        if (IN(PH_MLA_QKV) && mla) {
            { pg8::Gemm g{(const bf16_t*)(ws + opq(WS_CQ)), (const bf16_t*)(ws + opq(WS_W_MLA_UQ)) + (size_t)j * 3072 * 512, 512, 0}; pg8::StaticOrder S; S.init(T, 3072, G, bx);
              pg8::EpiMlaQ E{(bf16_t*)(ws + opq(WS_QN)), (bf16_t*)(ws + opq(WS_QR)), cs};
              pg8::gemm_phase<pg8::EpiMlaQ, pg8::StaticOrder, false>(lds + RING_OFF, g, S, E, wave); }
            { pg8::Gemm g{(const bf16_t*)(ws + opq(WS_CKV)), (const bf16_t*)(ws + opq(WS_W_MLA_UKV)) + (size_t)j * 4096 * 512, 512, 0}; pg8::StaticOrder S; S.init(T, 4096, G, bx);
              pg8::EpiBf16S E{(bf16_t*)(ws + opq(WS_KN)), 2048, 2048, (WS_V - WS_KN) / 2, 1.0f};
              pg8::gemm_phase<pg8::EpiBf16S, pg8::StaticOrder, false>(lds + RING_OFF, g, S, E, wave); }
            GRID_BAR();
        }
        if (IN(PH_MLA_ATT) && mla) {
            const att::Bufs B{(const bf16_t*)(ws + opq(WS_QN)), (const bf16_t*)(ws + opq(WS_KN)), (const bf16_t*)(ws + opq(WS_V)), (bf16_t*)(ws + opq(WS_QN)), (const bf16_t*)(ws + opq(WS_QR)), (const bf16_t*)(ws + opq(WS_KR)),
                              (const float*)(ws + opq(WS_NCK)), (const bf16_t*)(ws + opq(WS_QN))};
            att::attn_phase<0>((att::lptr)(lds + RING_OFF), B, vcu, G, wave);
            GRID_BAR();
        }
        if (IN(PH_MLA_WO) && mla) {
            pg8::Gemm g{(const bf16_t*)(ws + opq(WS_QN)), (const bf16_t*)(ws + opq(WS_W_MLA_O)) + (size_t)j * 2048 * 2048, 2048, 0}; pg8::StaticOrder S; S.init(T, 2048, G, bx);
            pg8::EpiRes E{h};
            pg8::gemm_phase<pg8::EpiRes, pg8::StaticOrder, false>(lds + RING_OFF, g, S, E, wave);
            GRID_BAR();
        }
        if (IN(PH_FOX_A) && !mla) {
            pg8::Gemm g{abf, (const bf16_t*)(ws + opq(WS_W_FOX_A)) + (size_t)j * 8448 * 2048, 2048, 0}; pg8::StaticOrder S; S.init(T, 8448, G, bx);
            pg8::EpiFoxA E{(bf16_t*)(ws + opq(WS_FQ)), (WS_FK - WS_FQ) / 2, (float*)(ws + opq(WS_LOGF)), args.in[opqi(16)] + j * 16};
            pg8::gemm_phase<pg8::EpiFoxA, pg8::StaticOrder, false>(lds + RING_OFF, g, S, E, wave);
            GRID_BAR();
        }
        if (IN(PH_FOX_PREP) && !mla) {
            const int tidx = wave * 64 + lane_id_v(); const int rlane = tidx & 63;
            if (gw < NB * NH) fox_scan_bh(gw, rlane, (const float*)(ws + opq(WS_LOGF)), (float*)(ws + opq(WS_NCK)));
            for (int row = gw; row < T; row += NGW) fox_qknorm_row(row, rlane, (bf16_t*)(ws + opq(WS_FQ)), (bf16_t*)(ws + opq(WS_FK)), args.in[opqi(13)] + j * 128, args.in[opqi(14)] + j * 128);
            GRID_BAR();
        }
        if (IN(PH_FOX_ATT) && !mla) {
            const att::Bufs B{(const bf16_t*)(ws + opq(WS_FQ)), (const bf16_t*)(ws + opq(WS_FK)), (const bf16_t*)(ws + opq(WS_FV)), (bf16_t*)(ws + opq(WS_FQ)), (const bf16_t*)(ws + opq(WS_FQ)), (const bf16_t*)(ws + opq(WS_FK)),
                              (const float*)(ws + opq(WS_NCK)), (const bf16_t*)(ws + opq(WS_FG))};
            att::attn_phase<1>((att::lptr)(lds + RING_OFF), B, vcu, G, wave);
            GRID_BAR();
        }
        if (IN(PH_FOX_WO) && !mla) {
            pg8::Gemm g{(const bf16_t*)(ws + opq(WS_FQ)), (const bf16_t*)(ws + opq(WS_W_FOX_O)) + (size_t)j * 2048 * 2048, 2048, 0}; pg8::StaticOrder S; S.init(T, 2048, G, bx);
            pg8::EpiRes E{h};
            pg8::gemm_phase<pg8::EpiRes, pg8::StaticOrder, false>(lds + RING_OFF, g, S, E, wave);
            GRID_BAR();
        }
        if (IN(PH_ROUTER)) {
            const int tidx = wave * 64 + lane_id_v();
            for (int it = vcu; it < T / 16; it += G)
                router_iter(lds + RING_OFF, tidx, it * 16, h, args.in[opqi(3)] + (size_t)L * D, (const float*)(ws + opq(WS_WRT)) + (size_t)L * 48 * 2048, args.in[opqi(20)] + L * 8, args.in[opqi(22)] + L * 32,
                            abf, ctl + CW_CNT + L * 64, (int*)(ws + opq(WS_ROWLIST)), (float*)(ws + opq(WS_ROWW)));
            GRID_BAR();
        }
        if (IN(PH_MOE_GU) || IN(PH_MOE_D)) {
            const unsigned* cnt = ctl + CW_CNT + L * 64; LAS int* pre = (LAS int*)(lds + 64);
            if (wave == 0 && lane_id_v() == 0) { int p = 0; for (int e = 0; e < NE; ++e) { pre[e] = p; p += ((int)cnt[e] + 255) >> 8; } pre[NE] = p; }
            __syncthreads();
            const int* rowlist = (const int*)(ws + opq(WS_ROWLIST)); const float* roww = (const float*)(ws + opq(WS_ROWW));
            if (IN(PH_MOE_GU)) {
                pg8::Gemm g{abf, (const bf16_t*)(ws + opq(WS_W_GU)) + (size_t)L * NE * 1024 * 2048, 2048, (size_t)1024 * 2048}; pg8::MoeOrder S; S.init(pre, rowlist, cnt, 4, G, bx);
                pg8::EpiGU E{(bf16_t*)(ws + opq(WS_HID))};
                pg8::gemm_phase<pg8::EpiGU, pg8::MoeOrder, true>(lds + RING_OFF, g, S, E, wave);
                GRID_BAR();
            }
            if (IN(PH_MOE_D)) {
                pg8::Gemm g{(const bf16_t*)(ws + opq(WS_HID)), (const bf16_t*)(ws + opq(WS_W_D)) + (size_t)L * NE * 2048 * 512, 512, (size_t)2048 * 512}; pg8::MoeOrder S; S.init(pre, rowlist, cnt, 8, G, bx);
                pg8::EpiDown E{y2, rowlist, roww, cnt};
                pg8::gemm_phase<pg8::EpiDown, pg8::MoeOrder, false>(lds + RING_OFF, g, S, E, wave);
                GRID_BAR();
            }
        }
    }
    { const int lo = args.ph_lo, hi = args.ph_hi, gw = vcu0 * 8 + wave, NGW = G0 * 8;
    if (IN(PH_FINAL) && args.L1 == 4) {
        const int tidx = wave * 64 + lane_id_v();
        for (int row = gw; row < T; row += NGW) norm_row<true>(row, tidx & 63, h, h, y2, true, false, args.in[opqi(4)], abf);
    } }
#undef IN
#undef GRID_BAR
}

#ifndef ONE_LAUNCH
#define ONE_LAUNCH 1
#endif
#ifndef FAST_GEMM
#define FAST_GEMM 1
#endif
#ifndef FAST_ATT_MLA
#define FAST_ATT_MLA 1
#endif
#ifndef FAST_ATT_FOX
#define FAST_ATT_FOX 1
#endif
#ifndef FAST_ROW
#define FAST_ROW 1
#endif
#ifndef FAST_ROUTER
#define FAST_ROUTER 1
#endif
#ifndef FAST_MOE
#define FAST_MOE 1
#endif
static void launch_mega(const Args& base, int L, int ph, int grid, hipStream_t stream) {
    Args a = base; a.L0 = L; a.L1 = L + 1; a.ph_lo = ph; a.ph_hi = ph + 1; a.use_bar = 0; a.pad = 0;
    hipLaunchKernelGGL(mega, dim3(grid), dim3(512), LDS_BYTES, stream, a);
}
extern "C" void kernel_launch(void* const* d_in, const int* in_sizes, int n_in, void* d_out, int out_size, void* d_ws, size_t ws_size, hipStream_t stream) {
    if (n_in != 26 || out_size != T * D || ws_size < WS_END) { fprintf(stderr, "kernel_launch: unexpected shapes (n_in %d, out %d, ws %zu)\n", n_in, out_size, ws_size); return; }
    static int grid = 0;
    if (grid == 0) {
        int dev = 0, cus = 0;
        if (hipGetDevice(&dev) != hipSuccess || hipDeviceGetAttribute(&cus, hipDeviceAttributeMultiprocessorCount, dev) != hipSuccess || cus <= 0) cus = 256;
        if (hipFuncSetAttribute((const void*)mega, hipFuncAttributeMaxDynamicSharedMemorySize, LDS_BYTES) != hipSuccess) { fprintf(stderr, "kernel_launch: hipFuncSetAttribute failed\n"); grid = -1; return; }
        int per_cu = 0; (void)hipOccupancyMaxActiveBlocksPerMultiprocessor(&per_cu, (const void*)mega, 512, LDS_BYTES); (void)hipGetLastError();
        if (per_cu < 1) fprintf(stderr, "kernel_launch: occupancy query reports %d blocks per CU\n", per_cu);
        grid = cus;
    }
    if (grid < 0) return;
    unsigned char* ws = (unsigned char*)d_ws;
    const float* x = (const float*)d_in[0]; const int* pos = (const int*)d_in[1];
    const float* attn_norm = (const float*)d_in[2]; const float* ffn_norm = (const float*)d_in[3]; const float* final_norm = (const float*)d_in[4];
    float* h = (float*)d_out;
    float2* cs = (float2*)(ws + WS_ROPE); float* logf = (float*)(ws + WS_LOGF); float* nck = (float*)(ws + WS_NCK);
    int* rowlist = (int*)(ws + WS_ROWLIST); float* roww = (float*)(ws + WS_ROWW); bf16_t* kr = (bf16_t*)(ws + WS_KR);
    bf16_t* abf = (bf16_t*)(ws + WS_ABF); bf16_t* y2 = (bf16_t*)(ws + WS_Y2);
    unsigned* ctl = (unsigned*)(ws + WS_CTL);
    (void)hipMemsetAsync(ws + WS_CTL, 0, CTL_BYTES, stream);
    Args base{}; for (int i = 0; i < 26; ++i) base.in[i] = (const float*)d_in[i]; base.out = h; base.ws = ws;
#if ONE_LAUNCH
    { Args a = base; a.L0 = 0; a.L1 = 4; a.ph_lo = 0; a.ph_hi = PH_END; a.use_bar = 1; a.pad = 0; hipLaunchKernelGGL(mega, dim3(grid), dim3(512), LDS_BYTES, stream, a); return; }
#endif
#if FAST_GEMM
    launch_mega(base, 0, PH_PRO, grid, stream);
#else
    k_rope_table<<<T * 32 / 256, 256, 0, stream>>>(pos, cs);
#endif
    for (int L = 0; L < 4; ++L) {
        const int j = L >> 1;
#if FAST_ROW
        launch_mega(base, L, PH_NORM, grid, stream);
#else
        if (L == 0) k_norm<0><<<T / 8, 512, 0, stream>>>(x, h, nullptr, attn_norm, abf);
        else k_norm<1><<<T / 8, 512, 0, stream>>>(h, h, y2, attn_norm + (size_t)L * D, abf);
#endif
        if ((L & 1) == 0) {
            bf16_t* raw = (bf16_t*)(ws + WS_RAW); bf16_t* cq = (bf16_t*)(ws + WS_CQ); bf16_t* ckv = (bf16_t*)(ws + WS_CKV);
            bf16_t* Qn = (bf16_t*)(ws + WS_QN); bf16_t* Qr = (bf16_t*)(ws + WS_QR); bf16_t* Kn = (bf16_t*)(ws + WS_KN); bf16_t* V = (bf16_t*)(ws + WS_V);
#if FAST_GEMM
            launch_mega(base, L, PH_MLA_A, grid, stream);
#else
            k_n_mla_a<<<dim3(3, T), 256, 0, stream>>>(abf, (const float*)d_in[5] + (size_t)j * D * 512, (const float*)d_in[8] + (size_t)j * D * 576, raw);
#endif
#if FAST_ROW
            launch_mega(base, L, PH_MLA_PREP, grid, stream);
#else
            k_mla_prep<<<T / 8, 512, 0, stream>>>(raw, (const float*)d_in[6] + j * 512, (const float*)d_in[9] + j * 512, cs, cq, ckv, kr);
#endif
#if FAST_GEMM
            launch_mega(base, L, PH_MLA_QKV, grid, stream);
#else
            k_n_mla_uq<<<dim3(6, T), 256, 0, stream>>>(cq, (const float*)d_in[7] + (size_t)j * 512 * 3072, cs, Qn, Qr);
            k_n_mla_ukv<<<dim3(8, T), 256, 0, stream>>>(ckv, (const float*)d_in[10] + (size_t)j * 512 * 4096, Kn, V);
#endif
#if FAST_ATT_MLA
            launch_mega(base, L, PH_MLA_ATT, grid, stream);
#else
            k_nattn<0><<<T * NH / 8, 512, 0, stream>>>(Qn, Qr, Kn, kr, V, nullptr, nullptr, Qn);
#endif
#if FAST_GEMM
            launch_mega(base, L, PH_MLA_WO, grid, stream);
#else
            k_n_wo<<<dim3(4, T), 256, 0, stream>>>(Qn, (const float*)d_in[11] + (size_t)j * D * D, h);
#endif
        } else {
            bf16_t* Q = (bf16_t*)(ws + WS_FQ); bf16_t* K = (bf16_t*)(ws + WS_FK); bf16_t* V = (bf16_t*)(ws + WS_FV); bf16_t* G = (bf16_t*)(ws + WS_FG);
#if FAST_GEMM
            launch_mega(base, L, PH_FOX_A, grid, stream);
#else
            k_n_fox_a<<<dim3(17, T), 256, 0, stream>>>(abf, (const float*)d_in[12] + (size_t)j * D * 6144, (const float*)d_in[17] + (size_t)j * D * D, (const float*)d_in[15] + (size_t)j * D * 16,
                                                     (const float*)d_in[16] + j * 16, Q, K, V, G, logf);
#endif
#if FAST_ROW
            launch_mega(base, L, PH_FOX_PREP, grid, stream);
#else
            k_fox_qknorm<<<T / 8, 512, 0, stream>>>(Q, K, (const float*)d_in[13] + j * 128, (const float*)d_in[14] + j * 128);
            k_fox_scan<<<NB * NH, 64, 0, stream>>>(logf, nck);
#endif
#if FAST_ATT_FOX
            launch_mega(base, L, PH_FOX_ATT, grid, stream);
#else
            k_nattn<1><<<T * NH / 8, 512, 0, stream>>>(Q, nullptr, K, nullptr, V, nck, G, Q);
#endif
#if FAST_GEMM
            launch_mega(base, L, PH_FOX_WO, grid, stream);
#else
            k_n_wo<<<dim3(4, T), 256, 0, stream>>>(Q, (const float*)d_in[18] + (size_t)j * D * D, h);
#endif
        }
        unsigned* cnt = ctl + CW_CNT + L * 64;
#if FAST_ROUTER
        launch_mega(base, L, PH_ROUTER, grid, stream);
#else
        k_n_router<<<T / 8, 512, 0, stream>>>(h, ffn_norm + (size_t)L * D, (const float*)d_in[19] + (size_t)L * D * 8, (const float*)d_in[20] + L * 8,
                                              (const float*)d_in[21] + (size_t)L * D * 32, (const float*)d_in[22] + L * 32, abf, cnt, rowlist, roww);
#endif
        bf16_t* hid = (bf16_t*)(ws + WS_HID);
#if FAST_MOE
        launch_mega(base, L, PH_MOE_GU, grid, stream);
        launch_mega(base, L, PH_MOE_D, grid, stream);
#else
        k_n_moe_gu<<<dim3(HID_ROWS, 2), 256, 0, stream>>>(abf, (const float*)d_in[23] + (size_t)L * NE * D * FF, (const float*)d_in[24] + (size_t)L * NE * D * FF, cnt, rowlist, hid);
        k_n_moe_d<<<dim3(HID_ROWS, 4), 256, 0, stream>>>(hid, (const float*)d_in[25] + (size_t)L * NE * FF * D, cnt, rowlist, roww, y2);
#endif
    }
#if FAST_ROW
    { Args a = base; a.L0 = 4; a.L1 = 4; a.ph_lo = PH_FINAL; a.ph_hi = PH_FINAL + 1; a.use_bar = 0; a.pad = 0; hipLaunchKernelGGL(mega, dim3(grid), dim3(512), LDS_BYTES, stream, a); }
#else
    k_norm<1><<<T / 8, 512, 0, stream>>>(h, h, y2, final_norm, abf);
    k_norm<2><<<T / 8, 512, 0, stream>>>(h, h, nullptr, final_norm, nullptr);
#endif
}
```
